# Optimizing an MI355X kernel written in HIP

```python
import math
import jax, jax.numpy as jnp
from jax import lax
import numpy as np

D_MODEL = 1024
BATCH = 4
SEQ = 4096
DEPTH = 1
DEC_BATCH = 16
DEC_SEQ = 32
PAST_LEN = 4096

CHUNK = 64
N_META = 16
HEAD_DIM = 64
SB_HEADS = 8
FOX_HEADS = 8
SB_WIDTH = SB_HEADS * HEAD_DIM
FOX_WIDTH = FOX_HEADS * HEAD_DIM
MIX_WIDTH = SB_WIDTH + FOX_WIDTH
IN_WIDTH = 4 * SB_WIDTH + 4 * FOX_WIDTH + FOX_HEADS
Q_BLOCK = 128
EPS = 1e-6

kernel_name = 'hymba_stickbreak_fox_stream_step'


def rmsnorm(x, g):
    xf = x.astype(jnp.float32)
    y = xf * lax.rsqrt(jnp.mean(xf * xf, axis=-1, keepdims=True) + EPS)
    return (y * g.astype(jnp.float32)).astype(x.dtype)


def project(h, g_norm, w_in, b_f):
    B, T, _ = h.shape
    u = rmsnorm(h, g_norm) @ w_in
    s, f = SB_WIDTH, FOX_WIDTH
    qa, ka, va, ga, qb, kb, vb, gb, fl = jnp.split(
        u, [s, 2 * s, 3 * s, 4 * s, 4 * s + f, 4 * s + 2 * f, 4 * s + 3 * f, 4 * s + 4 * f], axis=-1)
    heads = lambda t, n: t.reshape(B, T, n, HEAD_DIM)
    logf = jax.nn.log_sigmoid(fl.astype(jnp.float32) + b_f.astype(jnp.float32))
    return (heads(qa, SB_HEADS), heads(ka, SB_HEADS), heads(va, SB_HEADS), ga,
            heads(qb, FOX_HEADS), heads(kb, FOX_HEADS), heads(vb, FOX_HEADS), gb, logf)


def combine(h, oa, ga, ob, gb, w_out):
    B, T, _ = h.shape
    mixed = jnp.concatenate([oa.reshape(B, T, SB_WIDTH) * jax.nn.silu(ga),
                             ob.reshape(B, T, FOX_WIDTH) * jax.nn.silu(gb)], axis=-1)
    return h + mixed @ w_out


def sb_block(q, k, v, q_start):
    Tq, Tk = q.shape[1], k.shape[1]
    z = jnp.einsum('bqhd,bkhd->bhqk', q, k).astype(jnp.float32) * (1.0 / math.sqrt(HEAD_DIM))
    t_idx = q_start + jnp.arange(Tq)[:, None]
    s_idx = jnp.arange(Tk)[None, :]
    before = s_idx < t_idx
    log_keep = jnp.where(before, jax.nn.log_sigmoid(-z), 0.0)
    later = lax.cumsum(log_keep, axis=3, reverse=True) - log_keep
    w = jnp.where(before, jnp.exp(jax.nn.log_sigmoid(z) + later), 0.0)
    return jnp.einsum('bhqk,bkhd->bqhd', w.astype(v.dtype), v)


def fox_block(q, k, v, c, q_start):
    Tq, Tk = q.shape[1], k.shape[1]
    logits = jnp.einsum('bqhd,bkhd->bhqk', q, k).astype(jnp.float32) * (1.0 / math.sqrt(HEAD_DIM))
    c_q = jnp.transpose(c[:, q_start:q_start + Tq], (0, 2, 1))
    c_k = jnp.transpose(c, (0, 2, 1))
    decay = c_q[:, :, :, None] - c_k[:, :, None, :]
    causal = jnp.arange(Tk)[None, :] <= (q_start + jnp.arange(Tq)[:, None])
    p = jax.nn.softmax(jnp.where(causal, logits + decay, -jnp.inf), axis=-1)
    return jnp.einsum('bhqk,bkhd->bqhd', p.astype(v.dtype), v)


def attend_prompt(qa, ka, va, qb, kb, vb, logf):
    L = qa.shape[1]
    c = jnp.cumsum(logf, axis=1)
    oa, ob = [], []
    for start in range(0, L, Q_BLOCK):
        end = min(start + Q_BLOCK, L)
        oa.append(sb_block(qa[:, start:end], ka[:, :end], va[:, :end], start))
        ob.append(fox_block(qb[:, start:end], kb[:, :end], vb[:, :end], c[:, :end], start))
    return jnp.concatenate(oa, axis=1), jnp.concatenate(ob, axis=1)


def attend_sample(qa, ka, va, qb, kb, vb, logf, ck_a, cv_a, ck_b, cv_b, clogf):
    P = ck_a.shape[1]
    ka_all = jnp.concatenate([ck_a.astype(ka.dtype), ka], axis=1)
    va_all = jnp.concatenate([cv_a.astype(va.dtype), va], axis=1)
    kb_all = jnp.concatenate([ck_b.astype(kb.dtype), kb], axis=1)
    vb_all = jnp.concatenate([cv_b.astype(vb.dtype), vb], axis=1)
    c = jnp.cumsum(jnp.concatenate([clogf.astype(jnp.float32), logf], axis=1), axis=1)
    return sb_block(qa, ka_all, va_all, P), fox_block(qb, kb_all, vb_all, c, P)


def setup_inputs(seed: int = 0) -> dict:
    key = jax.random.key(seed)
    ks = jax.random.split(key, 14)
    nrm = jax.random.normal
    return {
        'x_prompt': nrm(ks[0], (BATCH, SEQ, D_MODEL), jnp.float32),
        'x_sample': nrm(ks[1], (DEC_BATCH, DEC_SEQ, D_MODEL), jnp.float32),
        'cache_a_k': nrm(ks[2], (DEPTH, DEC_BATCH, PAST_LEN, SB_HEADS, HEAD_DIM), jnp.float32),
        'cache_a_v': nrm(ks[3], (DEPTH, DEC_BATCH, PAST_LEN, SB_HEADS, HEAD_DIM), jnp.float32),
        'cache_b_k': nrm(ks[4], (DEPTH, DEC_BATCH, PAST_LEN, FOX_HEADS, HEAD_DIM), jnp.float32),
        'cache_b_v': nrm(ks[5], (DEPTH, DEC_BATCH, PAST_LEN, FOX_HEADS, HEAD_DIM), jnp.float32),
        'cache_b_logf': jax.nn.log_sigmoid(3.0 + nrm(ks[6], (DEPTH, DEC_BATCH, PAST_LEN, FOX_HEADS), jnp.float32)),
        'meta_tokens': nrm(ks[7], (N_META, D_MODEL), jnp.float32),
        'norm_g': 1.0 + 0.1 * nrm(ks[8], (DEPTH, D_MODEL), jnp.float32),
        'w_in': nrm(ks[9], (DEPTH, D_MODEL, IN_WIDTH), jnp.float32) * D_MODEL ** -0.5,
        'b_f': 2.0 + 2.0 * jax.random.uniform(ks[10], (DEPTH, FOX_HEADS), jnp.float32),
        'w_out': nrm(ks[11], (DEPTH, MIX_WIDTH, D_MODEL), jnp.float32) * MIX_WIDTH ** -0.5,
        'final_g': 1.0 + 0.1 * nrm(ks[12], (D_MODEL,), jnp.float32),
    }


def reference(x_prompt, x_sample, cache_a_k, cache_a_v, cache_b_k, cache_b_v, cache_b_logf,
              meta_tokens, norm_g, w_in, b_f, w_out, final_g):
    B = x_prompt.shape[0]
    meta = jnp.broadcast_to(meta_tokens[None].astype(x_prompt.dtype), (B, N_META, D_MODEL))
    hp = jnp.concatenate([meta, x_prompt], axis=1)
    hs = x_sample
    pak, pav, pbk, pbv, pbl = [], [], [], [], []
    sak, sav, sbk, sbv, sbl = [], [], [], [], []
    for l in range(DEPTH):
        qa, ka, va, ga, qb, kb, vb, gb, lf = project(hp, norm_g[l], w_in[l], b_f[l])
        oa, ob = attend_prompt(qa, ka, va, qb, kb, vb, lf)
        hp = combine(hp, oa, ga, ob, gb, w_out[l])
        pak.append(ka); pav.append(va); pbk.append(kb); pbv.append(vb); pbl.append(lf)
        qa, ka, va, ga, qb, kb, vb, gb, lf = project(hs, norm_g[l], w_in[l], b_f[l])
        oa, ob = attend_sample(qa, ka, va, qb, kb, vb, lf, cache_a_k[l], cache_a_v[l],
                               cache_b_k[l], cache_b_v[l], cache_b_logf[l])
        hs = combine(hs, oa, ga, ob, gb, w_out[l])
        sak.append(ka); sav.append(va); sbk.append(kb); sbv.append(vb); sbl.append(lf)
    y_prompt = rmsnorm(hp, final_g)[:, N_META:]
    y_sample = rmsnorm(hs, final_g)
    return (y_prompt, y_sample,
            jnp.stack(pak), jnp.stack(pav), jnp.stack(pbk), jnp.stack(pbv), jnp.stack(pbl),
            jnp.stack(sak), jnp.stack(sav), jnp.stack(sbk), jnp.stack(sbv), jnp.stack(sbl))
```

```cpp
#include <hip/hip_runtime.h>
#include <hip/hip_cooperative_groups.h>
#include <cstdio>
#include <cstdint>
namespace cg = cooperative_groups;

typedef unsigned short bf16_t;
typedef short bf16x8 __attribute__((ext_vector_type(8)));
typedef short s16x4 __attribute__((ext_vector_type(4)));
typedef float f32x16 __attribute__((ext_vector_type(16)));
typedef float f32x4 __attribute__((ext_vector_type(4)));
typedef float f32x2 __attribute__((ext_vector_type(2)));
typedef unsigned u32x4 __attribute__((ext_vector_type(4)));
typedef unsigned u32x2 __attribute__((ext_vector_type(2)));
typedef __bf16 bf16x2v __attribute__((ext_vector_type(2)));

#define DI __device__ __forceinline__
#define LDS_AS __attribute__((address_space(3)))
#define MFMA(a, b, c) __builtin_amdgcn_mfma_f32_32x32x16_bf16((a), (b), (c), 0, 0, 0)

constexpr int DM = 1024;
constexpr int NB = 4, SEQ = 4096, NMETA = 16, LP = 4112, LPAD = 4160;
constexpr int DB = 16, DSQ = 32, PAST = 4096, LSK = 4128;
constexpr int ROWS_P = NB * LPAD;
constexpr int ROWS_S = DB * DSQ;
constexpr int NR = ROWS_P + ROWS_S;
constexpr int INW = 4104;
constexpr int NU = 4096;
constexpr float EPS = 1e-6f;
constexpr float LOG2E = 1.4426950408889634f;
constexpr float QSCALE = 0.125f * LOG2E;
constexpr float SB_THRESH = 48.0f;

constexpr size_t O_YP = 0;
constexpr size_t O_YS = O_YP + (size_t)NB * SEQ * DM;
constexpr size_t PKV_SZ = (size_t)NB * LP * 512;
constexpr size_t SKV_SZ = (size_t)DB * DSQ * 512;
constexpr size_t O_PAK = O_YS + (size_t)DB * DSQ * DM;
constexpr size_t O_PBL = O_PAK + 4 * PKV_SZ;
constexpr size_t O_SAK = O_PBL + (size_t)NB * LP * 8;
constexpr size_t O_SBL = O_SAK + 4 * SKV_SZ;

#ifndef DUP_P1
#define DUP_P1 0
#endif
#ifndef DUP_P2
#define DUP_P2 0
#endif
constexpr int NT = 512, NW = 8;
constexpr int SMEM_BYTES = 131072 + 256;
constexpr int SM_UNIT_OFF = 131072 + 64;
constexpr int PART_STRIDE = 64 + 32 * 64;
constexpr int NSPLIT = 8;
constexpr int BIGT = 28, SMLT = (128 - 4 * BIGT) / 4;

struct Params {
    const float *x_prompt, *x_sample, *cak, *cav, *cbk, *cbv, *cbl, *meta, *norm_g, *w_in, *b_f, *w_out, *final_g;
    float* out;
    unsigned* ctrl; unsigned* bar; float* rowss; bf16_t *wtin, *wtout, *xn, *u, *mix; float *c2p, *c2s, *part;
};

DI unsigned pk2(float a, float b) { f32x2 v = {a, b}; bf16x2v r = __builtin_convertvector(v, bf16x2v); return __builtin_bit_cast(unsigned, r); }
DI float bflo(unsigned w) { return __uint_as_float(w << 16); }
DI float bfhi(unsigned w) { return __uint_as_float(w & 0xffff0000u); }
DI float wave_sum(float v) {
#pragma unroll
    for (int o = 32; o; o >>= 1) v += __shfl_xor(v, o);
    return v;
}
DI int crow(int i, int hh) { return (i & 3) + 8 * (i >> 2) + 4 * hh; }
DI float max3f(float a, float b, float c) { float r; asm("v_max3_f32 %0, %1, %2, %3" : "=v"(r) : "v"(a), "v"(b), "v"(c)); return r; }
DI float max2f(float a, float b) { float r; asm("v_max_f32_e32 %0, %1, %2" : "=v"(r) : "v"(a), "v"(b)); return r; }


#define XB_TMO      128
#define XB_XCNT(j)  (256  + 64 * (j))
#define XB_XSUB(j)  (1280 + 64 * (j))
#define XB_XGEN(j)  (2304 + 64 * (j))
#define XB_TOP      3328
#define XB_TOPGEN   3392
#define XCD_BAR_WORDS 3456
#define XB_SPIN_CAP (1u << 22)
DI unsigned xb_ld(unsigned* p)              { return __hip_atomic_load(p, __ATOMIC_RELAXED, __HIP_MEMORY_SCOPE_AGENT); }
DI unsigned xb_add(unsigned* p, unsigned v) { return __hip_atomic_fetch_add(p, v, __ATOMIC_RELAXED, __HIP_MEMORY_SCOPE_AGENT); }
DI unsigned xb_xcc_id() { return (unsigned)__builtin_amdgcn_s_getreg((3 << 11) | 20) & 0xFu; }
#define XB_SPIN(cond, bar) do { unsigned _sp = 0; while (cond) { __builtin_amdgcn_s_sleep(1); \
    if ((++_sp & 255u) == 0u) { if (xb_ld(&(bar)[XB_TMO])) break; if (_sp > XB_SPIN_CAP) { atomicAdd(&(bar)[XB_TMO], 1u); break; } } } } while (0)
struct XcdBarrier { unsigned* bar; unsigned x; volatile LDS_AS unsigned* st; };
DI XcdBarrier xcd_barrier_post(unsigned* bar, volatile LDS_AS unsigned* st) {
    XcdBarrier b; b.bar = bar; b.x = xb_xcc_id(); b.st = st;
    if (threadIdx.x == 0) (void)xb_add(&bar[XB_XCNT(b.x)], 1u);
    return b;
}
DI void xcd_barrier_complete(unsigned* bar, unsigned x, unsigned& nloc, unsigned& nx) {
    const unsigned G = gridDim.x * gridDim.y * gridDim.z;
    unsigned sum, cnt, mine, sp = 0u;
    for (;;) {
        sum = 0u; cnt = 0u; mine = 0u;
#pragma unroll
        for (unsigned j = 0; j < 16; ++j) { const unsigned c = xb_ld(&bar[XB_XCNT(j)]); sum += c; cnt += (c > 0u) ? 1u : 0u; mine = (j == x) ? c : mine; }
        if (sum == G) break;
        __builtin_amdgcn_s_sleep(1);
        if ((++sp & 255u) == 0u) { if (xb_ld(&bar[XB_TMO])) break; if (sp > XB_SPIN_CAP) { atomicAdd(&bar[XB_TMO], 1u); break; } }
    }
    nloc = mine > 0u ? mine : 1u; nx = cnt > 0u ? cnt : 1u;
}
DI void xcd_barrier(const XcdBarrier& b) {
    asm volatile("s_waitcnt vmcnt(0)" ::: "memory");
    __syncthreads();
    if (threadIdx.x == 0) {
        unsigned* bar = b.bar;
        __builtin_amdgcn_s_waitcnt(0);
        unsigned nloc = b.st[0], nx = b.st[1];
        if (nloc == 0u) { xcd_barrier_complete(bar, b.x, nloc, nx); b.st[0] = nloc; b.st[1] = nx; }
        const unsigned old = xb_add(&bar[XB_XSUB(b.x)], 1u);
        const unsigned gen = old / nloc;
        if (old + 1u == (gen + 1u) * nloc) {
            __builtin_amdgcn_fence(__ATOMIC_RELEASE, "agent");
            asm volatile("s_waitcnt vmcnt(0)" ::: "memory");
            const unsigned og = xb_add(&bar[XB_TOP], 1u);
            const unsigned tg = og / nx;
            if (og + 1u == (tg + 1u) * nx) xb_add(&bar[XB_TOPGEN], 1u);
            else XB_SPIN(xb_ld(&bar[XB_TOPGEN]) == tg, bar);
            __builtin_amdgcn_fence(__ATOMIC_ACQUIRE, "agent");
            xb_add(&bar[XB_XGEN(b.x)], 1u);
            asm volatile("s_waitcnt vmcnt(0)" ::: "memory");
        } else {
            XB_SPIN(xb_ld(&bar[XB_XGEN(b.x)]) == gen, bar);
            __builtin_amdgcn_fence(__ATOMIC_ACQUIRE, "agent");
            asm volatile("s_waitcnt vmcnt(0)" ::: "memory");
        }
    }
    __syncthreads();
}

DI void phase0(const Params& p, char* smem) {
    int tid_ = threadIdx.x; asm volatile("" : "+v"(tid_));
    const int tid = tid_, lane = tid & 63, wave = tid >> 6;
    float* tile = (float*)smem;
    for (int u = blockIdx.x; u < 1280; u += gridDim.x) {
        const float* src; int ld; bf16_t* dst;
        if (u < 1024) { const int kt = u >> 6, nt = u & 63; src = p.w_in + (size_t)(kt * 64) * INW + nt * 64; ld = INW; dst = p.wtin + (size_t)(nt * 64) * DM + kt * 64; }
        else { const int v = u - 1024, kt = v >> 4, nt = v & 15; src = p.w_out + (size_t)(kt * 64) * DM + nt * 64; ld = DM; dst = p.wtout + (size_t)(nt * 64) * DM + kt * 64; }
#pragma unroll
        for (int i = 0; i < 2; ++i) {
            const int r = (tid >> 4) + 32 * i, c = (tid & 15) * 4;
            const f32x4 v = *(const f32x4*)(src + (size_t)r * ld + c);
            tile[r * 65 + c] = v[0]; tile[r * 65 + c + 1] = v[1]; tile[r * 65 + c + 2] = v[2]; tile[r * 65 + c + 3] = v[3];
        }
        __syncthreads();
        {
            const int n = (tid >> 3), kc = (tid & 7) * 8;
            u32x4 w;
            w[0] = pk2(tile[(kc + 0) * 65 + n], tile[(kc + 1) * 65 + n]);
            w[1] = pk2(tile[(kc + 2) * 65 + n], tile[(kc + 3) * 65 + n]);
            w[2] = pk2(tile[(kc + 4) * 65 + n], tile[(kc + 5) * 65 + n]);
            w[3] = pk2(tile[(kc + 6) * 65 + n], tile[(kc + 7) * 65 + n]);
            *(u32x4*)(dst + (size_t)n * DM + kc) = w;
        }
        __syncthreads();
    }
    float* wf = (float*)smem;
#pragma unroll
    for (int i = 0; i < 2; ++i) {
        const int k = tid + 512 * i; const float* s = p.w_in + (size_t)k * INW + 4096;
        const f32x4 a = *(const f32x4*)s, b = *(const f32x4*)(s + 4);
        wf[0 * 1024 + k] = a[0]; wf[1 * 1024 + k] = a[1]; wf[2 * 1024 + k] = a[2]; wf[3 * 1024 + k] = a[3];
        wf[4 * 1024 + k] = b[0]; wf[5 * 1024 + k] = b[1]; wf[6 * 1024 + k] = b[2]; wf[7 * 1024 + k] = b[3];
    }
    __syncthreads();
    auto row_src = [&](int R) -> const float* {
        if (R < ROWS_P) {
            const int b = R / LPAD, t = R - b * LPAD;
            if (t >= LP) return nullptr;
            return t < NMETA ? p.meta + (size_t)t * DM : p.x_prompt + ((size_t)b * SEQ + t - NMETA) * DM;
        }
        return p.x_sample + (size_t)(R - ROWS_P) * DM;
    };
    f32x4 vn[4];
    {
        const int R0 = blockIdx.x * NW + wave;
        const float* s0 = R0 < NR ? row_src(R0) : nullptr; if (!s0) s0 = p.x_prompt;
#pragma unroll
        for (int i = 0; i < 4; ++i) vn[i] = *(const f32x4*)(s0 + i * 256 + lane * 4);
    }
    for (int R = blockIdx.x * NW + wave; R < NR; R += gridDim.x * NW) {
        const float* src = row_src(R); float* lf_out = nullptr;
        if (R < ROWS_P) { const int b = R / LPAD, t = R - b * LPAD; lf_out = p.out + O_PBL + ((size_t)b * LP + t) * 8; }
        else lf_out = p.out + O_SBL + (size_t)(R - ROWS_P) * 8;
        bf16_t* xr = p.xn + (size_t)R * DM;
        f32x4 v[4];
#pragma unroll
        for (int i = 0; i < 4; ++i) v[i] = vn[i];
        {
            const int Rn = R + gridDim.x * NW;
            const float* sn = Rn < NR ? row_src(Rn) : nullptr; if (!sn) sn = p.x_prompt;
#pragma unroll
            for (int i = 0; i < 4; ++i) vn[i] = *(const f32x4*)(sn + i * 256 + lane * 4);
        }
        if (!src) {
#pragma unroll
            for (int i = 0; i < 4; ++i) *(u32x2*)(xr + i * 256 + lane * 4) = (u32x2){0u, 0u};
            continue;
        }
        float ss = 0.f;
#pragma unroll
        for (int i = 0; i < 4; ++i) ss += v[i][0] * v[i][0] + v[i][1] * v[i][1] + v[i][2] * v[i][2] + v[i][3] * v[i][3];
        ss = wave_sum(ss);
        const float rstd = 1.0f / sqrtf(ss * (1.0f / 1024.0f) + EPS);
        float fa0 = 0, fa1 = 0, fa2 = 0, fa3 = 0, fa4 = 0, fa5 = 0, fa6 = 0, fa7 = 0;
#pragma unroll
        for (int i = 0; i < 4; ++i) {
            const int k = i * 256 + lane * 4;
            const f32x4 g = *(const f32x4*)(p.norm_g + k);
            const f32x4 xv = v[i] * rstd * g;
            *(u32x2*)(xr + k) = (u32x2){pk2(xv[0], xv[1]), pk2(xv[2], xv[3])};
            f32x4 w;
            w = *(const f32x4*)(wf + 0 * 1024 + k); fa0 += xv[0] * w[0] + xv[1] * w[1] + xv[2] * w[2] + xv[3] * w[3];
            w = *(const f32x4*)(wf + 1 * 1024 + k); fa1 += xv[0] * w[0] + xv[1] * w[1] + xv[2] * w[2] + xv[3] * w[3];
            w = *(const f32x4*)(wf + 2 * 1024 + k); fa2 += xv[0] * w[0] + xv[1] * w[1] + xv[2] * w[2] + xv[3] * w[3];
            w = *(const f32x4*)(wf + 3 * 1024 + k); fa3 += xv[0] * w[0] + xv[1] * w[1] + xv[2] * w[2] + xv[3] * w[3];
            w = *(const f32x4*)(wf + 4 * 1024 + k); fa4 += xv[0] * w[0] + xv[1] * w[1] + xv[2] * w[2] + xv[3] * w[3];
            w = *(const f32x4*)(wf + 5 * 1024 + k); fa5 += xv[0] * w[0] + xv[1] * w[1] + xv[2] * w[2] + xv[3] * w[3];
            w = *(const f32x4*)(wf + 6 * 1024 + k); fa6 += xv[0] * w[0] + xv[1] * w[1] + xv[2] * w[2] + xv[3] * w[3];
            w = *(const f32x4*)(wf + 7 * 1024 + k); fa7 += xv[0] * w[0] + xv[1] * w[1] + xv[2] * w[2] + xv[3] * w[3];
        }
        fa0 = wave_sum(fa0); fa1 = wave_sum(fa1); fa2 = wave_sum(fa2); fa3 = wave_sum(fa3);
        fa4 = wave_sum(fa4); fa5 = wave_sum(fa5); fa6 = wave_sum(fa6); fa7 = wave_sum(fa7);
        if (lane < 8) {
            float val = fa0;
            val = lane == 1 ? fa1 : val; val = lane == 2 ? fa2 : val; val = lane == 3 ? fa3 : val; val = lane == 4 ? fa4 : val;
            val = lane == 5 ? fa5 : val; val = lane == 6 ? fa6 : val; val = lane == 7 ? fa7 : val;
            const float z = val + p.b_f[lane];
            lf_out[lane] = fminf(z, 0.f) - log1pf(expf(-fabsf(z)));
        }
    }
    for (int i = blockIdx.x * NT + tid; i < NR; i += gridDim.x * NT) p.rowss[i] = 0.f;
    if (blockIdx.x == 0 && tid < 128) p.ctrl[tid] = 0u;
}

namespace pg8 {
#define PG8_LAS __attribute__((address_space(3)))
typedef unsigned short bf16_t;
typedef short bf16x8 __attribute__((ext_vector_type(8)));
typedef float f32x4 __attribute__((ext_vector_type(4)));
typedef unsigned u32x4 __attribute__((ext_vector_type(4)));
constexpr int BM = 256, BK = 64, HALF = 128, HTB = HALF * BK * 2  , STAGE_BYTES = 8 * HTB, NXCD = 8, WGM = 8;

__host__ __device__ __forceinline__ int lds_byte(int r, int c) { const int st = (r >> 4) * 2 + (c >> 5), rr = r & 15, cc = c & 31, ob = rr * 64 + cc * 2; return st * 1024 + (ob ^ (((ob >> 9) & 1) << 5)); }
__host__ __device__ __forceinline__ void stage_rc(int b, int& R, int& C) { const int st = b / 1024, sb = b % 1024, swz = sb ^ (((sb >> 9) & 1) << 5); R = (st >> 1) * 16 + swz / 64; C = (st & 1) * 32 + (swz % 64) / 2; }
__host__ __device__ __forceinline__ int perm32(int rho) { const int n = rho >> 4, i = rho & 15; return 8 * (i >> 2) + 4 * n + (i & 3); }

struct Unit { int pm, pn; };
struct Gemm { const bf16_t* A; const bf16_t* Bt; int M, N, K; };

struct StaticOrder {
    int nM, nN, nwg, G, c;
    __host__ __device__ void init(int M, int N, int G_, int c_) { nM = M / BM; nN = N / BM; nwg = nM * nN; G = G_; c = c_; }
    __host__ __device__ bool next(int i, Unit& u) const {
        const long L = (long)i * G + c; if (L >= nwg) return false;
        int wgid = (int)L; { const int q = nwg / NXCD, r = nwg % NXCD, xcd = wgid % NXCD, off = wgid / NXCD; wgid = (xcd < r ? xcd * (q + 1) : r * (q + 1) + (xcd - r) * q) + off; }
        const int nig = WGM * nN, gid = wgid / nig, fm = gid * WGM, gsz = (nM - fm) < WGM ? (nM - fm) : WGM;
        u.pm = fm + ((wgid % nig) % gsz); u.pn = (wgid % nig) / gsz; return true;
    }
    __device__ __forceinline__ void a_ready(const Unit&) const {}
    __device__ __forceinline__ void done(const Unit&) const {}
};

template <class Epi, class Sched, bool ALIGN_EPI = false, bool SP2 = false>
__device__ __forceinline__ void gemm_phase(PG8_LAS unsigned char* lds, const Gemm g, const Sched& S, const Epi& E) {
    const int tid = threadIdx.x, wid = __builtin_amdgcn_readfirstlane(tid >> 6), lane = tid & 63, wr = wid >> 2, wc = wid & 3, fr = lane & 15, fq = lane >> 4;
    const int K = g.K, nt = K / BK;
    unsigned voffA[2], voffB[2];
#pragma unroll
    for (int i = 0; i < 2; ++i) { int R, C; stage_rc(tid * 16 + i * 8192, R, C); const int Rb = Epi::PERM ? ((R & ~31) + perm32(R & 31)) : R;
        voffA[i] = (unsigned)(R * K + C) * 2u; voffB[i] = (unsigned)(Rb * K + C) * 2u; }
    const size_t kstep = (size_t)(BK * 2);
    const size_t hstep = (size_t)HALF * K * 2;
    const size_t tstep = 2 * hstep;
    const unsigned ldsw = (unsigned)wid * 1024u;
    const int aoff = lds_byte(wr * 64 + fr, fq * 8), boff = lds_byte(wc * 32 + fr, fq * 8);
#define PG8_SA(b, h) (((b) * 2 + (h)) * HTB)
#define PG8_SB(b, h) ((4 + (b) * 2 + (h)) * HTB)
#define PG8_STAGE(bufoff, gbase, voff) do { _Pragma("unroll") for (int _i = 0; _i < 2; ++_i) \
        __builtin_amdgcn_global_load_lds((const unsigned*)((const char*)(gbase) + (voff)[_i]), (PG8_LAS unsigned*)(lds + (bufoff) + ldsw + _i * 8192), 16, 0, 0); } while (0)
#define PG8_LDA(dst, b, h) do { _Pragma("unroll") for (int m = 0; m < 4; ++m) _Pragma("unroll") for (int k = 0; k < 2; ++k) dst[m][k] = *(const PG8_LAS bf16x8*)(lds + PG8_SA(b, h) + aoff + m * 2048 + k * 1024); } while (0)
#define PG8_LDB(dst, b, h) do { _Pragma("unroll") for (int n = 0; n < 2; ++n) _Pragma("unroll") for (int k = 0; k < 2; ++k) dst[n][k] = *(const PG8_LAS bf16x8*)(lds + PG8_SB(b, h) + boff + n * 2048 + k * 1024); } while (0)
#define PG8_MMA(ai, bj, At, Bt) do { __builtin_amdgcn_s_setprio(1); _Pragma("unroll") for (int m = 0; m < 4; ++m) _Pragma("unroll") for (int n = 0; n < 2; ++n) _Pragma("unroll") for (int k = 0; k < 2; ++k) \
        acc[ai][bj][m][n] = __builtin_amdgcn_mfma_f32_16x16x32_bf16(Bt[n][k], At[m][k], acc[ai][bj][m][n], 0, 0, 0); __builtin_amdgcn_s_setprio(0); } while (0)
#define PG8_WAIT_V(n) asm volatile("s_waitcnt vmcnt(" #n ")" ::: "memory")
#define PG8_WAIT_L(n) asm volatile("s_waitcnt lgkmcnt(" #n ")" ::: "memory")
#define PG8_BAR __builtin_amdgcn_s_barrier()
#define PG8_SCHED __builtin_amdgcn_sched_barrier(0)
    Unit cur, nxt; int ui = 0;
    if (!S.next(0, cur)) return;
    f32x4 acc[2][2][4][2];
#pragma unroll
    for (int a = 0; a < 2; ++a)
#pragma unroll
        for (int b = 0; b < 2; ++b)
#pragma unroll
            for (int m = 0; m < 4; ++m)
#pragma unroll
                for (int n = 0; n < 2; ++n) acc[a][b][m][n] = (f32x4){0.f, 0.f, 0.f, 0.f};
    bf16x8 At[4][2], B0[2][2], B1[2][2];
    const char* cA = (const char*)g.A + (size_t)cur.pm * tstep; const char* cB = (const char*)g.Bt + (size_t)cur.pn * tstep;
    S.a_ready(cur);
    if constexpr (SP2) {
        PG8_STAGE(PG8_SB(0, 0), cB, voffB); PG8_STAGE(PG8_SB(0, 1), cB + hstep, voffB); PG8_STAGE(PG8_SA(0, 0), cA, voffA); PG8_STAGE(PG8_SA(0, 1), cA + hstep, voffA);
        if (wr == 1) PG8_BAR;
        PG8_WAIT_V(2); PG8_BAR;
        PG8_STAGE(PG8_SB(1, 0), cB + kstep, voffB); PG8_STAGE(PG8_SA(1, 0), cA + kstep, voffA); PG8_STAGE(PG8_SB(1, 1), cB + hstep + kstep, voffB);
        PG8_WAIT_V(6); PG8_BAR;
    } else {
        PG8_STAGE(PG8_SB(0, 0), cB, voffB); PG8_STAGE(PG8_SA(0, 0), cA, voffA); PG8_STAGE(PG8_SB(0, 1), cB + hstep, voffB); PG8_STAGE(PG8_SA(0, 1), cA + hstep, voffA);
        if (wr == 1) PG8_BAR;
        PG8_WAIT_V(4); PG8_BAR;
        PG8_STAGE(PG8_SB(1, 0), cB + kstep, voffB); PG8_STAGE(PG8_SA(1, 0), cA + kstep, voffA); PG8_STAGE(PG8_SB(1, 1), cB + hstep + kstep, voffB);
        PG8_WAIT_V(6); PG8_BAR;
    }
    for (;;) {
        const bool has_next = S.next(ui + 1, nxt);
        const char* nA = has_next ? (const char*)g.A + (size_t)nxt.pm * tstep : cA; const char* nB = has_next ? (const char*)g.Bt + (size_t)nxt.pn * tstep : cB;
        for (int t = 0; t < nt; t += 2) {
            const bool last = (t == nt - 2);
            const char* a1 = cA + (size_t)(t + 1) * kstep;
            const char* a2 = last ? nA : cA + (size_t)(t + 2) * kstep; const char* b2 = last ? nB : cB + (size_t)(t + 2) * kstep;
            const char* a3 = a2 + kstep; const char* b3 = b2 + kstep;
            if (last && has_next) S.a_ready(nxt);
            if constexpr (SP2) {
            PG8_LDB(B0, 0, 0); PG8_LDB(B1, 0, 1); PG8_SCHED; PG8_LDA(At, 0, 0); PG8_STAGE(PG8_SA(1, 1), a1 + hstep, voffA);
            PG8_WAIT_V(8); PG8_WAIT_L(0); PG8_BAR; PG8_MMA(0, 0, At, B0); PG8_MMA(0, 1, At, B1); PG8_BAR; PG8_SCHED;
            PG8_LDA(At, 0, 1); PG8_STAGE(PG8_SB(0, 0), b2, voffB); PG8_STAGE(PG8_SB(0, 1), b2 + hstep, voffB); PG8_STAGE(PG8_SA(0, 0), a2, voffA);
            PG8_WAIT_V(8); PG8_WAIT_L(0); PG8_BAR; PG8_MMA(1, 0, At, B0); PG8_MMA(1, 1, At, B1); PG8_BAR; PG8_SCHED;
            PG8_LDB(B0, 1, 0); PG8_LDB(B1, 1, 1); PG8_SCHED; PG8_LDA(At, 1, 0); PG8_STAGE(PG8_SA(0, 1), a2 + hstep, voffA);
            PG8_WAIT_V(8); PG8_WAIT_L(0); PG8_BAR; PG8_MMA(0, 0, At, B0); PG8_MMA(0, 1, At, B1); PG8_BAR; PG8_SCHED;
            PG8_LDA(At, 1, 1); PG8_STAGE(PG8_SB(1, 0), b3, voffB); PG8_STAGE(PG8_SB(1, 1), b3 + hstep, voffB); PG8_STAGE(PG8_SA(1, 0), a3, voffA);
            PG8_WAIT_V(8); PG8_WAIT_L(0); PG8_BAR; PG8_MMA(1, 0, At, B0); PG8_MMA(1, 1, At, B1); PG8_BAR; PG8_SCHED;
            } else {
            PG8_LDB(B0, 0, 0); PG8_SCHED; PG8_LDA(At, 0, 0); PG8_STAGE(PG8_SA(1, 1), a1 + hstep, voffA);
            PG8_WAIT_L(8); PG8_BAR; PG8_WAIT_L(0); PG8_MMA(0, 0, At, B0); PG8_BAR; PG8_SCHED;
            PG8_LDB(B1, 0, 1); PG8_STAGE(PG8_SB(0, 0), b2, voffB);
            PG8_BAR; PG8_WAIT_L(0); PG8_MMA(0, 1, At, B1); PG8_BAR;
            PG8_LDA(At, 0, 1); PG8_STAGE(PG8_SA(0, 0), a2, voffA);
            PG8_BAR; PG8_WAIT_L(0); PG8_MMA(1, 0, At, B0); PG8_BAR; PG8_SCHED;
            PG8_STAGE(PG8_SB(0, 1), b2 + hstep, voffB);
            PG8_WAIT_V(6); PG8_BAR; PG8_MMA(1, 1, At, B1); PG8_BAR;
            PG8_LDB(B0, 1, 0); PG8_SCHED; PG8_LDA(At, 1, 0); PG8_STAGE(PG8_SA(0, 1), a2 + hstep, voffA);
            PG8_WAIT_L(8); PG8_BAR; PG8_WAIT_L(0); PG8_MMA(0, 0, At, B0); PG8_BAR; PG8_SCHED;
            PG8_LDB(B1, 1, 1); PG8_STAGE(PG8_SB(1, 0), b3, voffB);
            PG8_BAR; PG8_WAIT_L(0); PG8_MMA(0, 1, At, B1); PG8_BAR;
            PG8_LDA(At, 1, 1); PG8_STAGE(PG8_SA(1, 0), a3, voffA);
            PG8_BAR; PG8_WAIT_L(0); PG8_MMA(1, 0, At, B0); PG8_BAR; PG8_SCHED;
            PG8_STAGE(PG8_SB(1, 1), b3 + hstep, voffB);
            PG8_WAIT_V(6); PG8_BAR; PG8_MMA(1, 1, At, B1); PG8_BAR;
            }
        }
        if constexpr (ALIGN_EPI) { if (wr == 0) PG8_BAR; }
        if constexpr (!Epi::AFTER_DRAIN) { E(acc, cur, wr, wc, fr, fq); S.done(cur); }
        if (!has_next) break;
#pragma unroll
        for (int a = 0; a < 2; ++a)
#pragma unroll
            for (int b = 0; b < 2; ++b)
#pragma unroll
                for (int m = 0; m < 4; ++m)
#pragma unroll
                    for (int n = 0; n < 2; ++n) acc[a][b][m][n] = (f32x4){0.f, 0.f, 0.f, 0.f};
        cur = nxt; cA = nA; cB = nB; ++ui;
        if constexpr (ALIGN_EPI) { if (wr == 1) PG8_BAR; }
    }
    PG8_WAIT_V(0);
    if constexpr (!ALIGN_EPI) { if (wr == 0) PG8_BAR; }
    PG8_BAR;
    if constexpr (Epi::AFTER_DRAIN) { E.fused(acc, cur, wr, wc, fr, fq, lds, wid, lane); S.done(cur); }
#undef PG8_SA
#undef PG8_SB
#undef PG8_STAGE
#undef PG8_LDA
#undef PG8_LDB
#undef PG8_MMA
#undef PG8_WAIT_V
#undef PG8_WAIT_L
#undef PG8_BAR
#undef PG8_SCHED
}
}

struct EpiProj8 {
    static constexpr bool PERM = true, AFTER_DRAIN = false;
    const Params* pp;
    DI void operator()(const f32x4 (&acc)[2][2][4][2], const pg8::Unit& u, int wr, int wc, int fr, int fq) const {
        const Params& p = *pp;
        const int colt = u.pn * 256, seg = colt >> 9;
        const bool isq = (seg == 0) || (seg == 4), isg = (seg == 3) || (seg == 7), iskv = !isq && !isg;
        const int oi = seg == 1 ? 0 : seg == 2 ? 1 : seg == 5 ? 2 : 3;
#pragma unroll
        for (int ai = 0; ai < 2; ++ai)
#pragma unroll
            for (int m = 0; m < 4; ++m) {
                const int R = u.pm * 256 + ai * 128 + wr * 64 + m * 16 + fr;
                float* fo = nullptr;
                if (iskv) {
                    if (R < ROWS_P) { const int b = R / LPAD, t = R - b * LPAD; if (t < LP) fo = p.out + O_PAK + oi * PKV_SZ + ((size_t)b * LP + t) * 512 - seg * 512; }
                    else fo = p.out + O_SAK + oi * SKV_SZ + (size_t)(R - ROWS_P) * 512 - seg * 512;
                }
                bf16_t* uo = p.u + (size_t)R * NU;
#pragma unroll
                for (int bj = 0; bj < 2; ++bj) {
                    const int n = colt + bj * 128 + wc * 32 + 8 * fq;
                    f32x4 v0 = acc[ai][bj][m][0], v1 = acc[ai][bj][m][1];
                    if (fo) { *(f32x4*)(fo + n) = v0; *(f32x4*)(fo + n + 4) = v1; }
                    if (isq) { v0 = v0 * QSCALE; v1 = v1 * QSCALE; }
                    else if (isg) {
#pragma unroll
                        for (int j = 0; j < 4; ++j) { v0[j] = v0[j] / (1.0f + __expf(-v0[j])); v1[j] = v1[j] / (1.0f + __expf(-v1[j])); }
                    }
                    *(u32x4*)(uo + n) = (u32x4){pk2(v0[0], v0[1]), pk2(v0[2], v0[3]), pk2(v1[0], v1[1]), pk2(v1[2], v1[3])};
                }
            }
    }
};

struct EpiOut8 {
    static constexpr bool PERM = true, AFTER_DRAIN = false;
    const Params* pp;
    DI void operator()(const f32x4 (&acc)[2][2][4][2], const pg8::Unit& u, int wr, int wc, int fr, int fq) const {
        const Params& p = *pp;
        const int colt = u.pn * 256;
#pragma unroll
        for (int ai = 0; ai < 2; ++ai)
#pragma unroll
            for (int m = 0; m < 4; ++m) {
                const int R = u.pm * 256 + ai * 128 + wr * 64 + m * 16 + fr;
                const float* xs = nullptr; float* yd = nullptr;
                if (R < ROWS_P) { const int b = R / LPAD, t = R - b * LPAD; if (t >= NMETA && t < LP) { const size_t idx = ((size_t)b * SEQ + t - NMETA) * DM; xs = p.x_prompt + idx; yd = p.out + O_YP + idx; } }
                else { const size_t idx = (size_t)(R - ROWS_P) * DM; xs = p.x_sample + idx; yd = p.out + O_YS + idx; }
                float ss = 0.f;
                if (xs) {
#pragma unroll
                    for (int bj = 0; bj < 2; ++bj) {
                        const int n = colt + bj * 128 + wc * 32 + 8 * fq;
                        const f32x4 x0 = *(const f32x4*)(xs + n), x1 = *(const f32x4*)(xs + n + 4);
                        const f32x4 h0 = x0 + acc[ai][bj][m][0], h1 = x1 + acc[ai][bj][m][1];
                        *(f32x4*)(yd + n) = h0; *(f32x4*)(yd + n + 4) = h1;
                        ss += h0[0] * h0[0] + h0[1] * h0[1] + h0[2] * h0[2] + h0[3] * h0[3] + h1[0] * h1[0] + h1[1] * h1[1] + h1[2] * h1[2] + h1[3] * h1[3];
                    }
                }
                ss += __shfl_xor(ss, 16); ss += __shfl_xor(ss, 32);
                if (xs && fq == 0) atomicAdd(p.rowss + R, ss);
            }
    }
};

DI void scan_unit(const Params& p, int su) {
    const int lane = threadIdx.x & 63, wave = threadIdx.x >> 6;
    const int seq = su * NW + wave;
    const int e0 = lane * 65;
    if (seq < 32) {
        const int b = seq >> 3, h = seq & 7;
        const float* src = p.out + O_PBL + (size_t)b * LP * 8 + h;
        float* dst = p.c2p + (size_t)seq * LPAD;
        float s = 0.f;
        for (int i = 0; i < 65; ++i) { const int e = e0 + i; if (e < LP) s += src[(size_t)e * 8]; }
        float incl = s;
#pragma unroll
        for (int o = 1; o < 64; o <<= 1) { const float t = __shfl_up(incl, o); if (lane >= o) incl += t; }
        float run = incl - s;
        for (int i = 0; i < 65; ++i) { const int e = e0 + i; if (e < LP) { run += src[(size_t)e * 8]; dst[e] = run * LOG2E; } else dst[e] = 0.f; }
    } else {
        const int sq = seq - 32, bb = sq >> 3, h = sq & 7;
        const float* src0 = p.cbl + (size_t)bb * PAST * 8 + h;
        const float* src1 = p.out + O_SBL + (size_t)bb * DSQ * 8 + h;
        float* dst = p.c2s + (size_t)sq * LSK;
        float s = 0.f;
        for (int i = 0; i < 65; ++i) { const int e = e0 + i; if (e < PAST) s += src0[(size_t)e * 8]; else if (e < LSK) s += src1[(size_t)(e - PAST) * 8]; }
        float incl = s;
#pragma unroll
        for (int o = 1; o < 64; o <<= 1) { const float t = __shfl_up(incl, o); if (lane >= o) incl += t; }
        float run = incl - s;
        for (int i = 0; i < 65; ++i) {
            const int e = e0 + i;
            if (e < LSK) { run += (e < PAST) ? src0[(size_t)e * 8] : src1[(size_t)(e - PAST) * 8]; dst[e] = run * LOG2E; }
        }
    }
}

struct AttnState { f32x16 o0, o1; float m, l; };

template <int MODE>
DI void attn_subtile(LDS_AS const char* Kl, LDS_AS const char* Vl, LDS_AS const char* biasl, const bf16x8 (&q)[4], AttnState& st, int kpos0, int qpos, bool need_mask, int lane) {
    const int l31 = lane & 31, hh = lane >> 5;
    f32x16 s;
    if (MODE == 1) {
#pragma unroll
        for (int g = 0; g < 4; ++g) { const f32x4 bv = *(LDS_AS const f32x4*)(biasl + (8 * g + 4 * hh) * 4); s[4 * g] = bv[0]; s[4 * g + 1] = bv[1]; s[4 * g + 2] = bv[2]; s[4 * g + 3] = bv[3]; }
    } else {
#pragma unroll
        for (int i = 0; i < 16; ++i) s[i] = 0.f;
    }
#pragma unroll
    for (int stp = 0; stp < 4; ++stp) { const bf16x8 kf = *(LDS_AS const bf16x8*)(Kl + l31 * 144 + (2 * stp + hh) * 16); s = MFMA(kf, q[stp], s); }
    if (MODE == 1) {
        if (need_mask) {
#pragma unroll
            for (int i = 0; i < 16; ++i) if (kpos0 + crow(i, hh) > qpos) s[i] = -INFINITY;
        }
        float mx = s[0];
#pragma unroll
        for (int i = 1; i < 16; ++i) mx = fmaxf(mx, s[i]);
        mx = fmaxf(mx, __shfl_xor(mx, 32));
        const float mn = fmaxf(st.m, mx);
        if (__any(mn > st.m)) { const float a = __builtin_amdgcn_exp2f(st.m - mn); st.o0 = st.o0 * a; st.o1 = st.o1 * a; st.l *= a; }
        st.m = mn;
        float ps = 0.f;
#pragma unroll
        for (int i = 0; i < 16; ++i) { s[i] = __builtin_amdgcn_exp2f(s[i] - mn); ps += s[i]; }
        st.l += ps;
    } else {
        f32x16 lk;
#pragma unroll
        for (int i = 0; i < 16; ++i) {
            const float z = s[i];
            const float e = __builtin_amdgcn_exp2f(-fabsf(z));
            const float sp = __builtin_amdgcn_logf(1.0f + e);
            float lkv = -fmaxf(z, 0.f) - sp;
            float lsv = z + lkv;
            if (need_mask && (kpos0 + crow(i, hh) >= qpos)) { lkv = 0.f; lsv = -INFINITY; }
            lk[i] = lkv; s[i] = lsv;
        }
        float tot[4], suf1[4], suf0[4];
#pragma unroll
        for (int g = 0; g < 4; ++g) { suf1[g] = lk[4 * g + 3] + lk[4 * g + 2]; suf0[g] = suf1[g] + lk[4 * g + 1]; tot[g] = suf0[g] + lk[4 * g]; }
        float pb[4], cs[4];
#pragma unroll
        for (int g = 0; g < 4; ++g) { pb[g] = __shfl_xor(tot[g], 32); cs[g] = tot[g] + pb[g]; }
        const float S3 = 0.f, S2 = cs[3], S1 = S2 + cs[2], S0 = S1 + cs[1], total = S0 + cs[0];
        const float Sg[4] = {S0, S1, S2, S3};
#pragma unroll
        for (int g = 0; g < 4; ++g) {
            const float base = st.l + Sg[g] + (hh == 0 ? pb[g] : 0.f);
            s[4 * g + 3] = __builtin_amdgcn_exp2f(s[4 * g + 3] + base);
            s[4 * g + 2] = __builtin_amdgcn_exp2f(s[4 * g + 2] + (base + lk[4 * g + 3]));
            s[4 * g + 1] = __builtin_amdgcn_exp2f(s[4 * g + 1] + (base + suf1[g]));
            s[4 * g + 0] = __builtin_amdgcn_exp2f(s[4 * g + 0] + (base + suf0[g]));
        }
        st.l += total;
    }
    bf16x8 pf[2];
#pragma unroll
    for (int s2 = 0; s2 < 2; ++s2) {
        u32x4 w;
        w[0] = pk2(s[8 * s2 + 0], s[8 * s2 + 1]); w[1] = pk2(s[8 * s2 + 2], s[8 * s2 + 3]);
        w[2] = pk2(s[8 * s2 + 4], s[8 * s2 + 5]); w[3] = pk2(s[8 * s2 + 6], s[8 * s2 + 7]);
        pf[s2] = __builtin_bit_cast(bf16x8, w);
    }
    const int i16 = lane & 15, qq = i16 >> 2, pp = i16 & 3, gg = (lane >> 4) & 1;
#pragma unroll
    for (int s2 = 0; s2 < 2; ++s2)
#pragma unroll
        for (int dt = 0; dt < 2; ++dt) {
            LDS_AS const char* a_lo = Vl + (16 * s2 + 4 * hh + qq) * 144 + (32 * dt + 16 * gg + 4 * pp) * 2;
            const s16x4 lo = __builtin_amdgcn_ds_read_tr16_b64_v4i16((LDS_AS s16x4*)a_lo);
            const s16x4 hi = __builtin_amdgcn_ds_read_tr16_b64_v4i16((LDS_AS s16x4*)(a_lo + 8 * 144));
            const bf16x8 vf = __builtin_shufflevector(lo, hi, 0, 1, 2, 3, 4, 5, 6, 7);
            if (dt == 0) st.o0 = MFMA(vf, pf[s2], st.o0); else st.o1 = MFMA(vf, pf[s2], st.o1);
        }
}

DI void fox_softmax32(f32x16& s, AttnState& st, bf16x8 (&pf)[2]) {
    float mx = max2f(s[0], s[1]);
#pragma unroll
    for (int i = 2; i < 16; i += 2) mx = max3f(mx, s[i], s[i + 1]);
    mx = max2f(mx, __shfl_xor(mx, 32));
    const float mn = max2f(st.m, mx);
    if (__any(mn > st.m)) { const float a = __builtin_amdgcn_exp2f(st.m - mn); st.o0 = st.o0 * a; st.o1 = st.o1 * a; st.l *= a; }
    st.m = mn;
    const f32x2 mn2 = {mn, mn};
    f32x2 acc2 = {0.f, 0.f};
#pragma unroll
    for (int i = 0; i < 16; i += 2) {
        f32x2 t = {s[i], s[i + 1]};
        t = t - mn2;
        t[0] = __builtin_amdgcn_exp2f(t[0]); t[1] = __builtin_amdgcn_exp2f(t[1]);
        acc2 = acc2 + t;
        s[i] = t[0]; s[i + 1] = t[1];
    }
    st.l += acc2[0] + acc2[1];
#pragma unroll
    for (int s2 = 0; s2 < 2; ++s2) {
        u32x4 w;
        w[0] = pk2(s[8 * s2 + 0], s[8 * s2 + 1]); w[1] = pk2(s[8 * s2 + 2], s[8 * s2 + 3]); w[2] = pk2(s[8 * s2 + 4], s[8 * s2 + 5]); w[3] = pk2(s[8 * s2 + 6], s[8 * s2 + 7]);
        pf[s2] = __builtin_bit_cast(bf16x8, w);
    }
}
DI void fox_pv32(LDS_AS const char* Vl, const bf16x8 (&pf)[2], AttnState& st, int lane) {
    const int hh = lane >> 5, i16 = lane & 15, qq = i16 >> 2, pp = i16 & 3, gg = (lane >> 4) & 1;
#pragma unroll
    for (int s2 = 0; s2 < 2; ++s2)
#pragma unroll
        for (int dt = 0; dt < 2; ++dt) {
            LDS_AS const char* a_lo = Vl + (16 * s2 + 4 * hh + qq) * 144 + (32 * dt + 16 * gg + 4 * pp) * 2;
            const s16x4 lo = __builtin_amdgcn_ds_read_tr16_b64_v4i16((LDS_AS s16x4*)a_lo);
            const s16x4 hi = __builtin_amdgcn_ds_read_tr16_b64_v4i16((LDS_AS s16x4*)(a_lo + 8 * 144));
            const bf16x8 vf = __builtin_shufflevector(lo, hi, 0, 1, 2, 3, 4, 5, 6, 7);
            if (dt == 0) st.o0 = MFMA(vf, pf[s2], st.o0); else st.o1 = MFMA(vf, pf[s2], st.o1);
        }
}
DI void attn_tile64_fox(LDS_AS const char* Kl, LDS_AS const char* Vl, LDS_AS const char* biasl, const bf16x8 (&q)[4], AttnState& st, int lane) {
    const int l31 = lane & 31, hh = lane >> 5;
    f32x16 s0, s1;
#pragma unroll
    for (int g = 0; g < 4; ++g) {
        const f32x4 b0 = *(LDS_AS const f32x4*)(biasl + (8 * g + 4 * hh) * 4);
        const f32x4 b1 = *(LDS_AS const f32x4*)(biasl + 128 + (8 * g + 4 * hh) * 4);
        s0[4 * g] = b0[0]; s0[4 * g + 1] = b0[1]; s0[4 * g + 2] = b0[2]; s0[4 * g + 3] = b0[3];
        s1[4 * g] = b1[0]; s1[4 * g + 1] = b1[1]; s1[4 * g + 2] = b1[2]; s1[4 * g + 3] = b1[3];
    }
    bf16x8 k0[4], k1[4];
#pragma unroll
    for (int stp = 0; stp < 4; ++stp) {
        k1[stp] = *(LDS_AS const bf16x8*)(Kl + 32 * 144 + l31 * 144 + (2 * stp + hh) * 16);
        k0[stp] = *(LDS_AS const bf16x8*)(Kl + l31 * 144 + (2 * stp + hh) * 16);
    }
#pragma unroll
    for (int stp = 0; stp < 4; ++stp) s1 = MFMA(k1[stp], q[stp], s1);
#pragma unroll
    for (int stp = 0; stp < 4; ++stp) s0 = MFMA(k0[stp], q[stp], s0);
    __builtin_amdgcn_sched_barrier(0);
    bf16x8 pf1[2], pf0[2];
    fox_softmax32(s1, st, pf1);
    __builtin_amdgcn_sched_barrier(0);
    fox_pv32(Vl + 32 * 144, pf1, st, lane);
    __builtin_amdgcn_sched_barrier(0);
    fox_softmax32(s0, st, pf0);
    __builtin_amdgcn_sched_barrier(0);
    fox_pv32(Vl, pf0, st, lane);
}

DI void store_gated(const AttnState& st, const bf16_t* sg, bf16_t* mo, int hh) {
#pragma unroll
    for (int dt = 0; dt < 2; ++dt)
#pragma unroll
        for (int g = 0; g < 4; ++g) {
            const int d = 32 * dt + 8 * g + 4 * hh;
            const u32x2 gv = *(const u32x2*)(sg + d);
            const f32x16& o = dt == 0 ? st.o0 : st.o1;
            const float a0 = o[4 * g] * bflo(gv[0]), a1 = o[4 * g + 1] * bfhi(gv[0]), a2 = o[4 * g + 2] * bflo(gv[1]), a3 = o[4 * g + 3] * bfhi(gv[1]);
            *(u32x2*)(mo + d) = (u32x2){pk2(a0, a1), pk2(a2, a3)};
        }
}

constexpr int PSTG = 18688;

template <int MODE>
DI void prompt_unit(const Params& p, int b, int h, int qt, char* smem) {
    int tid_ = threadIdx.x; asm volatile("" : "+v"(tid_));
    const int tid = tid_, lane = tid & 63, wave = tid >> 6, l31 = lane & 31, hh = lane >> 5;
    LDS_AS char* lb = (LDS_AS char*)smem;
    const int t0 = qt * 256, wq0 = t0 + 32 * wave;
    const int qpos = wq0 + l31;
    const bool wave_valid = wq0 < LP;
    const int qcol = (MODE == 0 ? 0 : 2048) + h * 64, kcol = qcol + 512, vcol = qcol + 1024, gcol = qcol + 1536;
    const size_t rowb = (size_t)b * LPAD;
    bf16x8 q[4];
    {
        const int qr = qpos < LPAD ? qpos : LPAD - 1;
        const bf16_t* qp = p.u + (rowb + qr) * NU + qcol + 8 * hh;
#pragma unroll
        for (int s = 0; s < 4; ++s) q[s] = *(const bf16x8*)(qp + 16 * s);
    }
    AttnState st;
#pragma unroll
    for (int i = 0; i < 16; ++i) { st.o0[i] = 0.f; st.o1[i] = 0.f; }
    st.m = -1e30f; st.l = 0.f;
    const int kt_max = (4 * qt + 3) < 64 ? (4 * qt + 3) : 64;
    const float* cb = p.c2p + (size_t)(b * 8 + h) * LPAD;
    float cref = 0.f;
    if (MODE == 1) cref = cb[t0 < LP ? t0 : LP - 1];
    u32x4 rk, rv; float rbias = 0.f;
    const int r0 = tid >> 3, c0 = tid & 7;
    auto pload = [&](int kt) {
        const bf16_t* kb = p.u + (rowb + (size_t)kt * 64 + r0) * NU + c0 * 8;
        rk = *(const u32x4*)(kb + kcol); rv = *(const u32x4*)(kb + vcol);
        if (MODE == 1 && tid < 64) rbias = cref - cb[kt * 64 + tid];
    };
    auto pstore = [&](int sg) {
        LDS_AS char* base = lb + sg * PSTG + r0 * 144 + c0 * 16;
        *(LDS_AS u32x4*)(base) = rk; *(LDS_AS u32x4*)(base + 9216) = rv;
        if (MODE == 1 && tid < 64) *(LDS_AS float*)(lb + sg * PSTG + 18432 + tid * 4) = rbias;
    };
    __syncthreads();
    pload(kt_max); pstore(0);
    __syncthreads();
    int stg = 0;
    bool wdone = !wave_valid;
    for (int kt = kt_max; kt >= 0; --kt) {
        if (kt > 0) pload(kt - 1);
        if (!wdone) {
            LDS_AS const char* sb = lb + stg * PSTG;
            if (MODE == 1 && kt * 64 + 63 < wq0) attn_tile64_fox(sb, sb + 9216, sb + 18432, q, st, lane);
            else
#pragma unroll
            for (int sub = 1; sub >= 0; --sub) {
                const int kp0 = kt * 64 + sub * 32;
                if (kp0 <= wq0 + 31) {
                    const bool nm = (kp0 + 31 >= wq0);
                    attn_subtile<MODE>(sb + sub * 32 * 144, sb + 9216 + sub * 32 * 144, sb + 18432 + sub * 128, q, st, kp0, qpos, nm, lane);
                }
            }
            if (MODE == 0) wdone = __all(st.l < -SB_THRESH);
        }
        if (kt > 0) pstore(stg ^ 1);
        if (MODE == 0) { if (__syncthreads_and(wdone ? 1 : 0)) break; }
        else __syncthreads();
        stg ^= 1;
    }
    if (MODE == 1) { const float lt = st.l + __shfl_xor(st.l, 32); const float inv = 1.0f / lt; st.o0 = st.o0 * inv; st.o1 = st.o1 * inv; }
    if (wave_valid && qpos < LP) store_gated(st, p.u + (rowb + qpos) * NU + gcol, p.mix + (rowb + qpos) * DM + (MODE == 0 ? 0 : 512) + h * 64, hh);
}

DI void prompt_sb_unit(const Params& p, int b, int h, int qt, char* smem) {
    int tid_ = threadIdx.x; asm volatile("" : "+v"(tid_));
    const int tid = tid_, lane = tid & 63, wave = tid >> 6, l31 = lane & 31, hh = lane >> 5;
    LDS_AS char* lb = (LDS_AS char*)smem + wave * 9216;
    const int wq0 = qt * 256 + 32 * wave, qpos = wq0 + l31;
    const int qcol = h * 64, kcol = qcol + 512, vcol = qcol + 1024, gcol = qcol + 1536;
    const size_t rowb = (size_t)b * LPAD;
    __syncthreads();
    if (wq0 < LP) {
        bf16x8 q[4];
        {
            const bf16_t* qp = p.u + (rowb + qpos) * NU + qcol + 8 * hh;
#pragma unroll
            for (int s = 0; s < 4; ++s) q[s] = *(const bf16x8*)(qp + 16 * s);
        }
        AttnState st;
#pragma unroll
        for (int i = 0; i < 16; ++i) { st.o0[i] = 0.f; st.o1[i] = 0.f; }
        st.m = -1e30f; st.l = 0.f;
        u32x4 rk[4], rv[4];
        const int r0 = lane >> 3, c0 = lane & 7;
        const bf16_t* ub = p.u + (rowb + r0) * NU + c0 * 8;
        int kp = wq0;
        {
            const bf16_t* kb = ub + (size_t)kp * NU;
#pragma unroll
            for (int i = 0; i < 4; ++i) { rk[i] = *(const u32x4*)(kb + (size_t)(8 * i) * NU + kcol); rv[i] = *(const u32x4*)(kb + (size_t)(8 * i) * NU + vcol); }
        }
        for (;;) {
            asm volatile("s_waitcnt lgkmcnt(0)" ::: "memory");
#pragma unroll
            for (int i = 0; i < 4; ++i) { *(LDS_AS u32x4*)(lb + (r0 + 8 * i) * 144 + c0 * 16) = rk[i]; *(LDS_AS u32x4*)(lb + 4608 + (r0 + 8 * i) * 144 + c0 * 16) = rv[i]; }
            const int kn = kp - 32;
            if (kn >= 0) {
                const bf16_t* kb = ub + (size_t)kn * NU;
#pragma unroll
                for (int i = 0; i < 4; ++i) { rk[i] = *(const u32x4*)(kb + (size_t)(8 * i) * NU + kcol); rv[i] = *(const u32x4*)(kb + (size_t)(8 * i) * NU + vcol); }
            }
            asm volatile("s_waitcnt lgkmcnt(0)" ::: "memory");
            attn_subtile<0>(lb, lb + 4608, lb, q, st, kp, qpos, kp == wq0, lane);
            if (kn < 0 || __all(st.l < -SB_THRESH)) break;
            kp = kn;
        }
        if (qpos < LP) store_gated(st, p.u + (rowb + qpos) * NU + gcol, p.mix + (rowb + qpos) * DM + h * 64, hh);
    }
}

template <int MODE>
DI void sample_unit(const Params& p, int bb, int split, char* smem, int cq = 0) {
    int tid_ = threadIdx.x; asm volatile("" : "+v"(tid_));
    const int tid = tid_, lane = tid & 63, wave = tid >> 6, l31 = lane & 31, hh = lane >> 5;
    LDS_AS char* lb = (LDS_AS char*)smem;
    const int h = wave;
    const int qpos = PAST + l31;
    const size_t Rq = (size_t)ROWS_P + bb * 32 + l31;
    const int segb = (MODE == 0 ? 0 : 2048);
    const int qcol = segb + h * 64, gcol = qcol + 1536;
    bf16x8 q[4];
    {
        const bf16_t* qp = p.u + Rq * NU + qcol + 8 * hh;
#pragma unroll
        for (int s = 0; s < 4; ++s) q[s] = *(const bf16x8*)(qp + 16 * s);
    }
    AttnState st;
#pragma unroll
    for (int i = 0; i < 16; ++i) { st.o0[i] = 0.f; st.o1[i] = 0.f; }
    st.m = -1e30f; st.l = 0.f;
    const float* ck = (MODE == 0 ? p.cak : p.cbk) + (size_t)bb * PAST * 512;
    const float* cv = (MODE == 0 ? p.cav : p.cbv) + (size_t)bb * PAST * 512;
    const int ntc = (MODE == 1 ? (split < 4 ? BIGT : SMLT) : 128), kbase = (MODE == 1 ? 32 * (split < 4 ? split * BIGT : 4 * BIGT + (split - 4) * SMLT) : 0);
    const bool has_new = (MODE == 0) || (split == NSPLIT - 1);
    const float* cseq = p.c2s + (size_t)(bb * 8 + ((tid >> 5) & 7)) * LSK;
    float cref = 0.f;
    if (MODE == 1 && tid < 256) cref = cseq[PAST];
    constexpr int KOFF = 0, VOFF = 36864, BOFF = 73728, HSTR = 4608;
    bool wdone = false, alldone = false;
    if (has_new) {
        __syncthreads();
        const bf16_t* kb = p.u + ((size_t)ROWS_P + bb * 32) * NU + segb + 512;
#pragma unroll
        for (int i = 0; i < 4; ++i) {
            const int id = tid + 512 * i, r = id >> 6, c = id & 63, hd = c >> 3, d = (c & 7) * 8;
            const u32x4 kx = *(const u32x4*)(kb + (size_t)r * NU + c * 8);
            const u32x4 vx = *(const u32x4*)(kb + (size_t)r * NU + 512 + c * 8);
            *(LDS_AS u32x4*)(lb + KOFF + hd * HSTR + r * 144 + d * 2) = kx;
            *(LDS_AS u32x4*)(lb + VOFF + hd * HSTR + r * 144 + d * 2) = vx;
        }
        if (MODE == 1 && tid < 256) *(LDS_AS float*)(lb + BOFF + tid * 4) = cref - cseq[PAST + (tid & 31)];
        __syncthreads();
        attn_subtile<MODE>(lb + KOFF + wave * HSTR, lb + VOFF + wave * HSTR, lb + BOFF + wave * 128, q, st, PAST, qpos, true, lane);
        if (MODE == 0) { wdone = __all(st.l < -SB_THRESH); alldone = __syncthreads_and(wdone ? 1 : 0) != 0; }
    }
    if (!alldone) {
        f32x4 tk[8], tv[8]; float tb = 0.f;
        const int rot = (MODE == 1) ? ((bb * NSPLIT + split) * 5) % ntc : 0;
        {
            const int t0i = (ntc - 1 + rot) % ntc;
            const float* kg = ck + (size_t)(kbase + 32 * t0i) * 512;
            const float* vg = cv + (size_t)(kbase + 32 * t0i) * 512;
            if (MODE == 1 && tid < 256) tb = cseq[kbase + 32 * t0i + (tid & 31)];
#pragma unroll
            for (int i = 0; i < 8; ++i) { const int id = tid + 512 * i; tk[i] = __builtin_nontemporal_load((const f32x4*)(kg + (size_t)id * 4)); tv[i] = __builtin_nontemporal_load((const f32x4*)(vg + (size_t)id * 4)); }
        }
        for (int it = ntc - 1; it >= 0; --it) {
            const int kpos0 = kbase + 32 * ((it + rot) % ntc);
            const int kposn = kbase + 32 * ((it - 1 + rot + ntc) % ntc);
            __syncthreads();
#pragma unroll
            for (int i = 0; i < 8; ++i) {
                const int id = tid + 512 * i, r = id >> 7, c4 = id & 127, hd = c4 >> 4, d = (c4 & 15) * 4;
                *(LDS_AS u32x2*)(lb + KOFF + hd * HSTR + r * 144 + d * 2) = (u32x2){pk2(tk[i][0], tk[i][1]), pk2(tk[i][2], tk[i][3])};
                *(LDS_AS u32x2*)(lb + VOFF + hd * HSTR + r * 144 + d * 2) = (u32x2){pk2(tv[i][0], tv[i][1]), pk2(tv[i][2], tv[i][3])};
            }
            if (MODE == 1 && tid < 256) *(LDS_AS float*)(lb + BOFF + tid * 4) = cref - tb;
            if (it > 0) {
                const float* kg = ck + (size_t)kposn * 512;
                const float* vg = cv + (size_t)kposn * 512;
                if (MODE == 1 && tid < 256) tb = cseq[kposn + (tid & 31)];
#pragma unroll
                for (int i = 0; i < 8; ++i) { const int id = tid + 512 * i; tk[i] = __builtin_nontemporal_load((const f32x4*)(kg + (size_t)id * 4)); tv[i] = __builtin_nontemporal_load((const f32x4*)(vg + (size_t)id * 4)); }
            }
            __builtin_amdgcn_sched_barrier(0);
            __syncthreads();
            if (!wdone) {
                attn_subtile<MODE>(lb + KOFF + wave * HSTR, lb + VOFF + wave * HSTR, lb + BOFF + wave * 128, q, st, kpos0, qpos, false, lane);
                if (MODE == 0) wdone = __all(st.l < -SB_THRESH);
            }
            if (MODE == 0) { if (__syncthreads_and(wdone ? 1 : 0)) break; }
        }
    }
    if (MODE == 0) {
        store_gated(st, p.u + Rq * NU + gcol, p.mix + Rq * DM + h * 64, hh);
        return;
    }
    {
        const float lt = st.l + __shfl_xor(st.l, 32);
        float* pp = p.part + ((((size_t)bb * NSPLIT + split) * 8) + wave) * PART_STRIDE;
        if (hh == 0) { pp[l31] = st.m; pp[32 + l31] = lt; }
#pragma unroll
        for (int dt = 0; dt < 2; ++dt)
#pragma unroll
            for (int g = 0; g < 4; ++g) {
                const int d = 32 * dt + 8 * g + 4 * hh;
                const f32x16& o = dt == 0 ? st.o0 : st.o1;
                *(f32x4*)(pp + 64 + l31 * 64 + d) = (f32x4){o[4 * g], o[4 * g + 1], o[4 * g + 2], o[4 * g + 3]};
            }
    }
    asm volatile("s_waitcnt vmcnt(0)" ::: "memory");
    __syncthreads();
    LDS_AS int* sflag = (LDS_AS int*)((LDS_AS char*)smem + SM_UNIT_OFF + 4);
    if (tid == 0) {
        __builtin_amdgcn_fence(__ATOMIC_RELEASE, "agent");
        asm volatile("s_waitcnt vmcnt(0)" ::: "memory");
        const unsigned old = __hip_atomic_fetch_add(p.ctrl + cq + 8 + bb, 1u, __ATOMIC_RELAXED, __HIP_MEMORY_SCOPE_AGENT);
        const int lastf = (old == (unsigned)(NSPLIT - 1)) ? 1 : 0;
        if (lastf) { __builtin_amdgcn_fence(__ATOMIC_ACQUIRE, "agent"); asm volatile("s_waitcnt vmcnt(0)" ::: "memory"); }
        *sflag = lastf;
    }
    __syncthreads();
    const int last = *sflag;
    if (!last) return;
    {
        const int hd = tid >> 6, qi = (tid & 63) >> 1, d0 = (tid & 1) * 32;
        const float* pb = p.part + (((size_t)bb * NSPLIT) * 8 + hd) * PART_STRIDE;
        float M = -1e30f;
#pragma unroll 1
        for (int s = 0; s < NSPLIT; ++s) M = fmaxf(M, __builtin_nontemporal_load(pb + (size_t)s * 8 * PART_STRIDE + qi));
        float L = 0.f; float o[32];
#pragma unroll
        for (int j = 0; j < 32; ++j) o[j] = 0.f;
#pragma unroll 1
        for (int s = 0; s < NSPLIT; ++s) {
            const float* ps = pb + (size_t)s * 8 * PART_STRIDE;
            const float w = __builtin_amdgcn_exp2f(__builtin_nontemporal_load(ps + qi) - M);
            L += w * __builtin_nontemporal_load(ps + 32 + qi);
#pragma unroll
            for (int j = 0; j < 8; ++j) { const f32x4 v = *(const f32x4*)(ps + 64 + qi * 64 + d0 + 4 * j); o[4 * j] += w * v[0]; o[4 * j + 1] += w * v[1]; o[4 * j + 2] += w * v[2]; o[4 * j + 3] += w * v[3]; }
        }
        const float inv = 1.0f / L;
        const size_t R = (size_t)ROWS_P + bb * 32 + qi;
        const int hcol = hd * 64 + d0;
        const bf16_t* sg = p.u + R * NU + 3584 + hcol;
        bf16_t* mo = p.mix + R * DM + 512 + hcol;
#pragma unroll
        for (int j = 0; j < 8; ++j) {
            const u32x2 gv = *(const u32x2*)(sg + 4 * j);
            *(u32x2*)(mo + 4 * j) = (u32x2){pk2(o[4 * j] * inv * bflo(gv[0]), o[4 * j + 1] * inv * bfhi(gv[0])), pk2(o[4 * j + 2] * inv * bflo(gv[1]), o[4 * j + 3] * inv * bfhi(gv[1]))};
        }
    }
}

constexpr int NU_SF = DB * NSPLIT, NU_PF = 32 * 17, NU_SS = DB, NU_PS = 32 * 17;

__global__ void __launch_bounds__(512, 2) hymba_mega(Params p) {
    extern __shared__ __attribute__((aligned(16))) char smem[];
    const int tid = threadIdx.x;
    volatile LDS_AS unsigned* xbst = (volatile LDS_AS unsigned*)((LDS_AS char*)smem + 131072);
    if (tid == 0) { xbst[0] = 0u; xbst[1] = 0u; xbst[2] = 0u; xbst[3] = 0u; }
    __syncthreads();
    const XcdBarrier xb = xcd_barrier_post(p.bar, xbst);

    phase0(p, smem);
    xcd_barrier(xb);

    {
        const int su = (int)gridDim.x - 1 - (int)blockIdx.x;
        if (su < 20) scan_unit(p, su);
        __syncthreads();
        pg8::StaticOrder S; S.init(NR, 4096, (int)gridDim.x, (int)blockIdx.x);
        const pg8::Gemm g{p.xn, p.wtin, NR, 4096, DM};
        const EpiProj8 E{&p};
        pg8::gemm_phase<EpiProj8, pg8::StaticOrder, true, true>((PG8_LAS unsigned char*)smem, g, S, E);
        xcd_barrier(xb);
#if DUP_P1
        pg8::gemm_phase<EpiProj8, pg8::StaticOrder, true, true>((PG8_LAS unsigned char*)smem, g, S, E);
        xcd_barrier(xb);
#endif
    }

    for (int rep = 0; rep < 1 + DUP_P2; ++rep) {
        const int cq = rep * 64;
        LDS_AS int* sunit = (LDS_AS int*)((LDS_AS char*)smem + SM_UNIT_OFF);
#define QUEUE_LOOP(QI, NUNITS, BODY) \
        for (;;) { \
            __syncthreads(); \
            if (tid == 0) *sunit = (int)atomicAdd(p.ctrl + cq + (QI), 1u); \
            __syncthreads(); \
            const int u = *sunit; \
            if (u >= (NUNITS)) break; \
            BODY; \
        }
        const bool streamer = ((blockIdx.x >> 3) & 3) == 0;
        for (int ph = 0; ph < 4; ++ph) {
            const int qi = streamer ? (ph == 0 ? 0 : ph == 1 ? 2 : ph == 2 ? 1 : 3) : (ph == 0 ? 1 : ph == 1 ? 0 : ph == 2 ? 2 : 3);
            if (qi == 0) { QUEUE_LOOP(0, NU_SF, sample_unit<1>(p, (u & 63) >> 2, (u & 3) + ((u >> 6) << 2), smem, cq)) }
            else if (qi == 1) { QUEUE_LOOP(1, NU_PF, prompt_unit<1>(p, (u & 31) >> 3, u & 7, 16 - (u >> 5), smem)) }
            else if (qi == 2) { QUEUE_LOOP(2, NU_SS, sample_unit<0>(p, u, 0, smem)) }
            else { QUEUE_LOOP(3, NU_PS, prompt_sb_unit(p, (u & 31) >> 3, u & 7, 16 - (u >> 5), smem)) }
        }
        xcd_barrier(xb);
    }

    {
        pg8::StaticOrder S; S.init(NR, DM, (int)gridDim.x, (int)blockIdx.x);
        const pg8::Gemm g{p.mix, p.wtout, NR, DM, DM};
        const EpiOut8 E{&p};
        pg8::gemm_phase<EpiOut8, pg8::StaticOrder, true, true>((PG8_LAS unsigned char*)smem, g, S, E);
    }
    xcd_barrier(xb);

    {
        const int lane = tid & 63, wave = tid >> 6;
        auto row_dst = [&](int R) -> float* {
            if (R < ROWS_P) { const int b = R / LPAD, t = R - b * LPAD; if (t >= NMETA && t < LP) return p.out + O_YP + ((size_t)b * SEQ + t - NMETA) * DM; return nullptr; }
            return p.out + O_YS + (size_t)(R - ROWS_P) * DM;
        };
        f32x4 gq[4];
#pragma unroll
        for (int i = 0; i < 4; ++i) gq[i] = *(const f32x4*)(p.final_g + i * 256 + lane * 4);
        f32x4 vn[4]; float rn;
        {
            const int R0 = blockIdx.x * NW + wave;
            float* d0 = R0 < NR ? row_dst(R0) : nullptr; if (!d0) d0 = p.out + O_YS;
            rn = p.rowss[R0 < NR ? R0 : 0];
#pragma unroll
            for (int i = 0; i < 4; ++i) vn[i] = *(const f32x4*)(d0 + i * 256 + lane * 4);
        }
        for (int R = blockIdx.x * NW + wave; R < NR; R += gridDim.x * NW) {
            float* yd = row_dst(R);
            f32x4 v[4]; const float rs = rn;
#pragma unroll
            for (int i = 0; i < 4; ++i) v[i] = vn[i];
            {
                const int Rn = R + gridDim.x * NW;
                float* dn = Rn < NR ? row_dst(Rn) : nullptr; if (!dn) dn = p.out + O_YS;
                rn = p.rowss[Rn < NR ? Rn : 0];
#pragma unroll
                for (int i = 0; i < 4; ++i) vn[i] = *(const f32x4*)(dn + i * 256 + lane * 4);
            }
            if (!yd) continue;
            const float rstd = 1.0f / sqrtf(rs * (1.0f / 1024.0f) + EPS);
#pragma unroll
            for (int i = 0; i < 4; ++i) *(f32x4*)(yd + i * 256 + lane * 4) = v[i] * rstd * gq[i];
        }
    }
}

static inline size_t align_up(size_t x) { return (x + 255) & ~(size_t)255; }

extern "C" void kernel_launch(void* const* d_in, const int* in_sizes, int n_in, void* d_out, int out_size, void* d_ws, size_t ws_size, hipStream_t stream) {
    Params p{};
    p.x_prompt = (const float*)d_in[0]; p.x_sample = (const float*)d_in[1];
    p.cak = (const float*)d_in[2]; p.cav = (const float*)d_in[3]; p.cbk = (const float*)d_in[4]; p.cbv = (const float*)d_in[5]; p.cbl = (const float*)d_in[6];
    p.meta = (const float*)d_in[7]; p.norm_g = (const float*)d_in[8]; p.w_in = (const float*)d_in[9]; p.b_f = (const float*)d_in[10];
    p.w_out = (const float*)d_in[11]; p.final_g = (const float*)d_in[12];
    p.out = (float*)d_out;
    char* w = (char*)d_ws; size_t off = 0;
    p.ctrl = (unsigned*)(w + off); off = align_up(off + 4096);
    p.bar = (unsigned*)(w + off); off = align_up(off + XCD_BAR_WORDS * 4);
    p.rowss = (float*)(w + off); off = align_up(off + (size_t)NR * 4);
    p.wtin = (bf16_t*)(w + off); off = align_up(off + (size_t)4096 * DM * 2);
    p.wtout = (bf16_t*)(w + off); off = align_up(off + (size_t)DM * DM * 2);
    p.xn = (bf16_t*)(w + off); off = align_up(off + (size_t)NR * DM * 2);
    p.u = (bf16_t*)(w + off); off = align_up(off + (size_t)NR * NU * 2);
    p.mix = (bf16_t*)(w + off); off = align_up(off + (size_t)NR * DM * 2);
    p.c2p = (float*)(w + off); off = align_up(off + (size_t)32 * LPAD * 4);
    p.c2s = (float*)(w + off); off = align_up(off + (size_t)128 * LSK * 4);
    p.part = (float*)(w + off); off = align_up(off + (size_t)DB * NSPLIT * 8 * PART_STRIDE * 4);
    static int grid_blocks = 0;
    if (!grid_blocks) {
        int dev = 0, cus = 0, per_cu = 0;
        hipGetDevice(&dev);
        hipFuncSetAttribute((const void*)hymba_mega, hipFuncAttributeMaxDynamicSharedMemorySize, SMEM_BYTES);
        hipDeviceGetAttribute(&cus, hipDeviceAttributeMultiprocessorCount, dev);
        hipOccupancyMaxActiveBlocksPerMultiprocessor(&per_cu, hymba_mega, NT, SMEM_BYTES);
        if (per_cu > 1) per_cu = 1;
        grid_blocks = cus * per_cu;
        if (grid_blocks <= 0) grid_blocks = 256;
    }
    hipMemsetAsync(p.bar, 0, XCD_BAR_WORDS * 4, stream);
    void* args[] = {&p};
    hipError_t e = hipLaunchCooperativeKernel((void*)hymba_mega, dim3(grid_blocks), dim3(NT), args, SMEM_BYTES, stream);
    if (e != hipSuccess) fprintf(stderr, "cooperative launch failed: %s (grid %d)\n", hipGetErrorString(e), grid_blocks);
}
```

```cpp
#include <hip/hip_runtime.h>
#include <hip/hip_cooperative_groups.h>
#include <cstdio>
#include <cstdint>
namespace cg = cooperative_groups;

typedef unsigned short bf16_t;
typedef short bf16x8 __attribute__((ext_vector_type(8)));
typedef short s16x4 __attribute__((ext_vector_type(4)));
typedef float f32x16 __attribute__((ext_vector_type(16)));
typedef float f32x4 __attribute__((ext_vector_type(4)));
typedef float f32x2 __attribute__((ext_vector_type(2)));
typedef unsigned u32x4 __attribute__((ext_vector_type(4)));
typedef unsigned u32x2 __attribute__((ext_vector_type(2)));
typedef __bf16 bf16x2v __attribute__((ext_vector_type(2)));

#define DI __device__ __forceinline__
#define LDS_AS __attribute__((address_space(3)))
#define MFMA(a, b, c) __builtin_amdgcn_mfma_f32_32x32x16_bf16((a), (b), (c), 0, 0, 0)

constexpr int DM = 1024;
constexpr int NB = 4, SEQ = 4096, NMETA = 16, LP = 4112, LPAD = 4160;
constexpr int DB = 16, DSQ = 32, PAST = 4096, LSK = 4128;
constexpr int ROWS_P = NB * LPAD;
constexpr int ROWS_S = DB * DSQ;
constexpr int NR = ROWS_P + ROWS_S;
constexpr int INW = 4104;
constexpr int NU = 4096;
constexpr float EPS = 1e-6f;
constexpr float LOG2E = 1.4426950408889634f;
constexpr float QSCALE = 0.125f * LOG2E;
constexpr float SB_THRESH = 48.0f;

constexpr size_t O_YP = 0;
constexpr size_t O_YS = O_YP + (size_t)NB * SEQ * DM;
constexpr size_t PKV_SZ = (size_t)NB * LP * 512;
constexpr size_t SKV_SZ = (size_t)DB * DSQ * 512;
constexpr size_t O_PAK = O_YS + (size_t)DB * DSQ * DM;
constexpr size_t O_PBL = O_PAK + 4 * PKV_SZ;
constexpr size_t O_SAK = O_PBL + (size_t)NB * LP * 8;
constexpr size_t O_SBL = O_SAK + 4 * SKV_SZ;

#ifndef DUP_P1
#define DUP_P1 0
#endif
#ifndef DUP_P2
#define DUP_P2 0
#endif
constexpr int NT = 512, NW = 8;
constexpr int SMEM_BYTES = 131072 + 256;
constexpr int SM_UNIT_OFF = 131072 + 64;
constexpr int PART_STRIDE = 64 + 32 * 64;
constexpr int NSPLIT = 4;

struct Params {
    const float *x_prompt, *x_sample, *cak, *cav, *cbk, *cbv, *cbl, *meta, *norm_g, *w_in, *b_f, *w_out, *final_g;
    float* out;
    unsigned* ctrl; unsigned* bar; float* rowss; bf16_t *wtin, *wtout, *xn, *u, *mix; float *c2p, *c2s, *part;
};

DI unsigned pk2(float a, float b) { f32x2 v = {a, b}; bf16x2v r = __builtin_convertvector(v, bf16x2v); return __builtin_bit_cast(unsigned, r); }
DI float bflo(unsigned w) { return __uint_as_float(w << 16); }
DI float bfhi(unsigned w) { return __uint_as_float(w & 0xffff0000u); }
DI float wave_sum(float v) {
#pragma unroll
    for (int o = 32; o; o >>= 1) v += __shfl_xor(v, o);
    return v;
}
DI int crow(int i, int hh) { return (i & 3) + 8 * (i >> 2) + 4 * hh; }
DI float max3f(float a, float b, float c) { float r; asm("v_max3_f32 %0, %1, %2, %3" : "=v"(r) : "v"(a), "v"(b), "v"(c)); return r; }
DI float max2f(float a, float b) { float r; asm("v_max_f32_e32 %0, %1, %2" : "=v"(r) : "v"(a), "v"(b)); return r; }


#define XB_TMO      128
#define XB_XCNT(j)  (256  + 64 * (j))
#define XB_XSUB(j)  (1280 + 64 * (j))
#define XB_XGEN(j)  (2304 + 64 * (j))
#define XB_TOP      3328
#define XB_TOPGEN   3392
#define XCD_BAR_WORDS 3456
#define XB_SPIN_CAP (1u << 22)
DI unsigned xb_ld(unsigned* p)              { return __hip_atomic_load(p, __ATOMIC_RELAXED, __HIP_MEMORY_SCOPE_AGENT); }
DI unsigned xb_add(unsigned* p, unsigned v) { return __hip_atomic_fetch_add(p, v, __ATOMIC_RELAXED, __HIP_MEMORY_SCOPE_AGENT); }
DI unsigned xb_xcc_id() { return (unsigned)__builtin_amdgcn_s_getreg((3 << 11) | 20) & 0xFu; }
#define XB_SPIN(cond, bar) do { unsigned _sp = 0; while (cond) { __builtin_amdgcn_s_sleep(1); \
    if ((++_sp & 255u) == 0u) { if (xb_ld(&(bar)[XB_TMO])) break; if (_sp > XB_SPIN_CAP) { atomicAdd(&(bar)[XB_TMO], 1u); break; } } } } while (0)
struct XcdBarrier { unsigned* bar; unsigned x; volatile LDS_AS unsigned* st; };
DI XcdBarrier xcd_barrier_post(unsigned* bar, volatile LDS_AS unsigned* st) {
    XcdBarrier b; b.bar = bar; b.x = xb_xcc_id(); b.st = st;
    if (threadIdx.x == 0) (void)xb_add(&bar[XB_XCNT(b.x)], 1u);
    return b;
}
DI void xcd_barrier_complete(unsigned* bar, unsigned x, unsigned& nloc, unsigned& nx) {
    const unsigned G = gridDim.x * gridDim.y * gridDim.z;
    unsigned sum, cnt, mine, sp = 0u;
    for (;;) {
        sum = 0u; cnt = 0u; mine = 0u;
#pragma unroll
        for (unsigned j = 0; j < 16; ++j) { const unsigned c = xb_ld(&bar[XB_XCNT(j)]); sum += c; cnt += (c > 0u) ? 1u : 0u; mine = (j == x) ? c : mine; }
        if (sum == G) break;
        __builtin_amdgcn_s_sleep(1);
        if ((++sp & 255u) == 0u) { if (xb_ld(&bar[XB_TMO])) break; if (sp > XB_SPIN_CAP) { atomicAdd(&bar[XB_TMO], 1u); break; } }
    }
    nloc = mine > 0u ? mine : 1u; nx = cnt > 0u ? cnt : 1u;
}
DI void xcd_barrier(const XcdBarrier& b) {
    asm volatile("s_waitcnt vmcnt(0)" ::: "memory");
    __syncthreads();
    if (threadIdx.x == 0) {
        unsigned* bar = b.bar;
        __builtin_amdgcn_s_waitcnt(0);
        unsigned nloc = b.st[0], nx = b.st[1];
        if (nloc == 0u) { xcd_barrier_complete(bar, b.x, nloc, nx); b.st[0] = nloc; b.st[1] = nx; }
        const unsigned old = xb_add(&bar[XB_XSUB(b.x)], 1u);
        const unsigned gen = old / nloc;
        if (old + 1u == (gen + 1u) * nloc) {
            __builtin_amdgcn_fence(__ATOMIC_RELEASE, "agent");
            asm volatile("s_waitcnt vmcnt(0)" ::: "memory");
            const unsigned og = xb_add(&bar[XB_TOP], 1u);
            const unsigned tg = og / nx;
            if (og + 1u == (tg + 1u) * nx) xb_add(&bar[XB_TOPGEN], 1u);
            else XB_SPIN(xb_ld(&bar[XB_TOPGEN]) == tg, bar);
            __builtin_amdgcn_fence(__ATOMIC_ACQUIRE, "agent");
            xb_add(&bar[XB_XGEN(b.x)], 1u);
            asm volatile("s_waitcnt vmcnt(0)" ::: "memory");
        } else {
            XB_SPIN(xb_ld(&bar[XB_XGEN(b.x)]) == gen, bar);
            __builtin_amdgcn_fence(__ATOMIC_ACQUIRE, "agent");
            asm volatile("s_waitcnt vmcnt(0)" ::: "memory");
        }
    }
    __syncthreads();
}

DI void phase0(const Params& p, char* smem) {
    int tid_ = threadIdx.x; asm volatile("" : "+v"(tid_));
    const int tid = tid_, lane = tid & 63, wave = tid >> 6;
    float* tile = (float*)smem;
    for (int u = blockIdx.x; u < 1280; u += gridDim.x) {
        const float* src; int ld; bf16_t* dst;
        if (u < 1024) { const int kt = u >> 6, nt = u & 63; src = p.w_in + (size_t)(kt * 64) * INW + nt * 64; ld = INW; dst = p.wtin + (size_t)(nt * 64) * DM + kt * 64; }
        else { const int v = u - 1024, kt = v >> 4, nt = v & 15; src = p.w_out + (size_t)(kt * 64) * DM + nt * 64; ld = DM; dst = p.wtout + (size_t)(nt * 64) * DM + kt * 64; }
#pragma unroll
        for (int i = 0; i < 2; ++i) {
            const int r = (tid >> 4) + 32 * i, c = (tid & 15) * 4;
            const f32x4 v = *(const f32x4*)(src + (size_t)r * ld + c);
            tile[r * 65 + c] = v[0]; tile[r * 65 + c + 1] = v[1]; tile[r * 65 + c + 2] = v[2]; tile[r * 65 + c + 3] = v[3];
        }
        __syncthreads();
        {
            const int n = (tid >> 3), kc = (tid & 7) * 8;
            u32x4 w;
            w[0] = pk2(tile[(kc + 0) * 65 + n], tile[(kc + 1) * 65 + n]);
            w[1] = pk2(tile[(kc + 2) * 65 + n], tile[(kc + 3) * 65 + n]);
            w[2] = pk2(tile[(kc + 4) * 65 + n], tile[(kc + 5) * 65 + n]);
            w[3] = pk2(tile[(kc + 6) * 65 + n], tile[(kc + 7) * 65 + n]);
            *(u32x4*)(dst + (size_t)n * DM + kc) = w;
        }
        __syncthreads();
    }
    float* wf = (float*)smem;
#pragma unroll
    for (int i = 0; i < 2; ++i) {
        const int k = tid + 512 * i; const float* s = p.w_in + (size_t)k * INW + 4096;
        const f32x4 a = *(const f32x4*)s, b = *(const f32x4*)(s + 4);
        wf[0 * 1024 + k] = a[0]; wf[1 * 1024 + k] = a[1]; wf[2 * 1024 + k] = a[2]; wf[3 * 1024 + k] = a[3];
        wf[4 * 1024 + k] = b[0]; wf[5 * 1024 + k] = b[1]; wf[6 * 1024 + k] = b[2]; wf[7 * 1024 + k] = b[3];
    }
    __syncthreads();
    auto row_src = [&](int R) -> const float* {
        if (R < ROWS_P) {
            const int b = R / LPAD, t = R - b * LPAD;
            if (t >= LP) return nullptr;
            return t < NMETA ? p.meta + (size_t)t * DM : p.x_prompt + ((size_t)b * SEQ + t - NMETA) * DM;
        }
        return p.x_sample + (size_t)(R - ROWS_P) * DM;
    };
    LDS_AS const char* wfl = (LDS_AS const char*)smem;
    f32x4 gq[4];
#pragma unroll
    for (int i = 0; i < 4; ++i) gq[i] = *(const f32x4*)(p.norm_g + i * 256 + lane * 4);
    const float bfv = p.b_f[lane >> 3];
    f32x4 vn[4];
    {
        const int R0 = blockIdx.x * NW + wave;
        const float* s0 = R0 < NR ? row_src(R0) : nullptr; if (!s0) s0 = p.x_prompt;
#pragma unroll
        for (int i = 0; i < 4; ++i) vn[i] = *(const f32x4*)(s0 + i * 256 + lane * 4);
    }
    for (int R = blockIdx.x * NW + wave; R < NR; R += gridDim.x * NW) {
        const float* src = row_src(R); float* lf_out = nullptr;
        if (R < ROWS_P) { const int b = R / LPAD, t = R - b * LPAD; lf_out = p.out + O_PBL + ((size_t)b * LP + t) * 8; }
        else lf_out = p.out + O_SBL + (size_t)(R - ROWS_P) * 8;
        bf16_t* xr = p.xn + (size_t)R * DM;
        f32x4 v[4];
#pragma unroll
        for (int i = 0; i < 4; ++i) v[i] = vn[i];
        {
            const int Rn = R + gridDim.x * NW;
            const float* sn = Rn < NR ? row_src(Rn) : nullptr; if (!sn) sn = p.x_prompt;
#pragma unroll
            for (int i = 0; i < 4; ++i) vn[i] = *(const f32x4*)(sn + i * 256 + lane * 4);
        }
        if (!src) {
#pragma unroll
            for (int i = 0; i < 4; ++i) *(u32x2*)(xr + i * 256 + lane * 4) = (u32x2){0u, 0u};
            continue;
        }
        float ss = 0.f;
#pragma unroll
        for (int i = 0; i < 4; ++i) ss += v[i][0] * v[i][0] + v[i][1] * v[i][1] + v[i][2] * v[i][2] + v[i][3] * v[i][3];
        ss = wave_sum(ss);
        const float rstd = 1.0f / sqrtf(ss * (1.0f / 1024.0f) + EPS);
        float fa[8];
#pragma unroll
        for (int j = 0; j < 8; ++j) fa[j] = 0.f;
#pragma unroll
        for (int i = 0; i < 4; ++i) {
            const int k = i * 256 + lane * 4;
            const f32x4 xv = v[i] * rstd * gq[i];
            *(u32x2*)(xr + k) = (u32x2){pk2(xv[0], xv[1]), pk2(xv[2], xv[3])};
#pragma unroll
            for (int j = 0; j < 8; ++j) { const f32x4 w = *(LDS_AS const f32x4*)(wfl + (j * 1024 + k) * 4); fa[j] += xv[0] * w[0] + xv[1] * w[1] + xv[2] * w[2] + xv[3] * w[3]; }
        }
        const bool h5 = (lane & 32) != 0, h4 = (lane & 16) != 0, h3 = (lane & 8) != 0;
        float a4[4], a2[2];
#pragma unroll
        for (int j = 0; j < 4; ++j) { const float keep = h5 ? fa[4 + j] : fa[j], send = h5 ? fa[j] : fa[4 + j]; a4[j] = keep + __shfl_xor(send, 32); }
#pragma unroll
        for (int j = 0; j < 2; ++j) { const float keep = h4 ? a4[2 + j] : a4[j], send = h4 ? a4[j] : a4[2 + j]; a2[j] = keep + __shfl_xor(send, 16); }
        float c1;
        { const float keep = h3 ? a2[1] : a2[0], send = h3 ? a2[0] : a2[1]; c1 = keep + __shfl_xor(send, 8); }
        c1 += __shfl_xor(c1, 4); c1 += __shfl_xor(c1, 2); c1 += __shfl_xor(c1, 1);
        if ((lane & 7) == 0) {
            const float z = c1 + bfv;
            lf_out[lane >> 3] = fminf(z, 0.f) - log1pf(expf(-fabsf(z)));
        }
    }
    for (int i = blockIdx.x * NT + tid; i < NR; i += gridDim.x * NT) p.rowss[i] = 0.f;
    if (blockIdx.x == 0 && tid < 128) p.ctrl[tid] = 0u;
}

namespace pg8 {
#define PG8_LAS __attribute__((address_space(3)))
typedef unsigned short bf16_t;
typedef short bf16x8 __attribute__((ext_vector_type(8)));
typedef float f32x4 __attribute__((ext_vector_type(4)));
typedef unsigned u32x4 __attribute__((ext_vector_type(4)));
constexpr int BM = 256, BK = 64, HALF = 128, HTB = HALF * BK * 2  , STAGE_BYTES = 8 * HTB, NXCD = 8, WGM = 8;

__host__ __device__ __forceinline__ int lds_byte(int r, int c) { const int st = (r >> 4) * 2 + (c >> 5), rr = r & 15, cc = c & 31, ob = rr * 64 + cc * 2; return st * 1024 + (ob ^ (((ob >> 9) & 1) << 5)); }
__host__ __device__ __forceinline__ void stage_rc(int b, int& R, int& C) { const int st = b / 1024, sb = b % 1024, swz = sb ^ (((sb >> 9) & 1) << 5); R = (st >> 1) * 16 + swz / 64; C = (st & 1) * 32 + (swz % 64) / 2; }
__host__ __device__ __forceinline__ int perm32(int rho) { const int n = rho >> 4, i = rho & 15; return 8 * (i >> 2) + 4 * n + (i & 3); }

struct Unit { int pm, pn; };
struct Gemm { const bf16_t* A; const bf16_t* Bt; int M, N, K; };

struct StaticOrder {
    int nM, nN, nwg, G, c;
    __host__ __device__ void init(int M, int N, int G_, int c_) { nM = M / BM; nN = N / BM; nwg = nM * nN; G = G_; c = c_; }
    __host__ __device__ bool next(int i, Unit& u) const {
        const long L = (long)i * G + c; if (L >= nwg) return false;
        int wgid = (int)L; { const int q = nwg / NXCD, r = nwg % NXCD, xcd = wgid % NXCD, off = wgid / NXCD; wgid = (xcd < r ? xcd * (q + 1) : r * (q + 1) + (xcd - r) * q) + off; }
        const int nig = WGM * nN, gid = wgid / nig, fm = gid * WGM, gsz = (nM - fm) < WGM ? (nM - fm) : WGM;
        u.pm = fm + ((wgid % nig) % gsz); u.pn = (wgid % nig) / gsz; return true;
    }
    __device__ __forceinline__ void a_ready(const Unit&) const {}
    __device__ __forceinline__ void done(const Unit&) const {}
};

template <class Epi, class Sched, bool ALIGN_EPI = false, bool SP2 = false>
__device__ __forceinline__ void gemm_phase(PG8_LAS unsigned char* lds, const Gemm g, const Sched& S, const Epi& E) {
    const int tid = threadIdx.x, wid = __builtin_amdgcn_readfirstlane(tid >> 6), lane = tid & 63, wr = wid >> 2, wc = wid & 3, fr = lane & 15, fq = lane >> 4;
    const int K = g.K, nt = K / BK;
    unsigned voffA[2], voffB[2];
#pragma unroll
    for (int i = 0; i < 2; ++i) { int R, C; stage_rc(tid * 16 + i * 8192, R, C); const int Rb = Epi::PERM ? ((R & ~31) + perm32(R & 31)) : R;
        voffA[i] = (unsigned)(R * K + C) * 2u; voffB[i] = (unsigned)(Rb * K + C) * 2u; }
    const size_t kstep = (size_t)(BK * 2);
    const size_t hstep = (size_t)HALF * K * 2;
    const size_t tstep = 2 * hstep;
    const unsigned ldsw = (unsigned)wid * 1024u;
    const int aoff = lds_byte(wr * 64 + fr, fq * 8), boff = lds_byte(wc * 32 + fr, fq * 8);
#define PG8_SA(b, h) (((b) * 2 + (h)) * HTB)
#define PG8_SB(b, h) ((4 + (b) * 2 + (h)) * HTB)
#define PG8_STAGE(bufoff, gbase, voff) do { _Pragma("unroll") for (int _i = 0; _i < 2; ++_i) \
        __builtin_amdgcn_global_load_lds((const unsigned*)((const char*)(gbase) + (voff)[_i]), (PG8_LAS unsigned*)(lds + (bufoff) + ldsw + _i * 8192), 16, 0, 0); } while (0)
#define PG8_LDA(dst, b, h) do { _Pragma("unroll") for (int m = 0; m < 4; ++m) _Pragma("unroll") for (int k = 0; k < 2; ++k) dst[m][k] = *(const PG8_LAS bf16x8*)(lds + PG8_SA(b, h) + aoff + m * 2048 + k * 1024); } while (0)
#define PG8_LDB(dst, b, h) do { _Pragma("unroll") for (int n = 0; n < 2; ++n) _Pragma("unroll") for (int k = 0; k < 2; ++k) dst[n][k] = *(const PG8_LAS bf16x8*)(lds + PG8_SB(b, h) + boff + n * 2048 + k * 1024); } while (0)
#define PG8_MMA(ai, bj, At, Bt) do { __builtin_amdgcn_s_setprio(1); _Pragma("unroll") for (int m = 0; m < 4; ++m) _Pragma("unroll") for (int n = 0; n < 2; ++n) _Pragma("unroll") for (int k = 0; k < 2; ++k) \
        acc[ai][bj][m][n] = __builtin_amdgcn_mfma_f32_16x16x32_bf16(Bt[n][k], At[m][k], acc[ai][bj][m][n], 0, 0, 0); __builtin_amdgcn_s_setprio(0); } while (0)
#define PG8_WAIT_V(n) asm volatile("s_waitcnt vmcnt(" #n ")" ::: "memory")
#define PG8_WAIT_L(n) asm volatile("s_waitcnt lgkmcnt(" #n ")" ::: "memory")
#define PG8_BAR __builtin_amdgcn_s_barrier()
#define PG8_SCHED __builtin_amdgcn_sched_barrier(0)
    Unit cur, nxt; int ui = 0;
    if (!S.next(0, cur)) return;
    f32x4 acc[2][2][4][2];
#pragma unroll
    for (int a = 0; a < 2; ++a)
#pragma unroll
        for (int b = 0; b < 2; ++b)
#pragma unroll
            for (int m = 0; m < 4; ++m)
#pragma unroll
                for (int n = 0; n < 2; ++n) acc[a][b][m][n] = (f32x4){0.f, 0.f, 0.f, 0.f};
    bf16x8 At[4][2], B0[2][2], B1[2][2];
    const char* cA = (const char*)g.A + (size_t)cur.pm * tstep; const char* cB = (const char*)g.Bt + (size_t)cur.pn * tstep;
    S.a_ready(cur);
    if constexpr (SP2) {
        PG8_STAGE(PG8_SB(0, 0), cB, voffB); PG8_STAGE(PG8_SB(0, 1), cB + hstep, voffB); PG8_STAGE(PG8_SA(0, 0), cA, voffA); PG8_STAGE(PG8_SA(0, 1), cA + hstep, voffA);
        if (wr == 1) PG8_BAR;
        PG8_WAIT_V(2); PG8_BAR;
        PG8_STAGE(PG8_SB(1, 0), cB + kstep, voffB); PG8_STAGE(PG8_SA(1, 0), cA + kstep, voffA); PG8_STAGE(PG8_SB(1, 1), cB + hstep + kstep, voffB);
        PG8_WAIT_V(6); PG8_BAR;
    } else {
        PG8_STAGE(PG8_SB(0, 0), cB, voffB); PG8_STAGE(PG8_SA(0, 0), cA, voffA); PG8_STAGE(PG8_SB(0, 1), cB + hstep, voffB); PG8_STAGE(PG8_SA(0, 1), cA + hstep, voffA);
        if (wr == 1) PG8_BAR;
        PG8_WAIT_V(4); PG8_BAR;
        PG8_STAGE(PG8_SB(1, 0), cB + kstep, voffB); PG8_STAGE(PG8_SA(1, 0), cA + kstep, voffA); PG8_STAGE(PG8_SB(1, 1), cB + hstep + kstep, voffB);
        PG8_WAIT_V(6); PG8_BAR;
    }
    for (;;) {
        const bool has_next = S.next(ui + 1, nxt);
        const char* nA = has_next ? (const char*)g.A + (size_t)nxt.pm * tstep : cA; const char* nB = has_next ? (const char*)g.Bt + (size_t)nxt.pn * tstep : cB;
        for (int t = 0; t < nt; t += 2) {
            const bool last = (t == nt - 2);
            const char* a1 = cA + (size_t)(t + 1) * kstep;
            const char* a2 = last ? nA : cA + (size_t)(t + 2) * kstep; const char* b2 = last ? nB : cB + (size_t)(t + 2) * kstep;
            const char* a3 = a2 + kstep; const char* b3 = b2 + kstep;
            if (last && has_next) S.a_ready(nxt);
            if constexpr (SP2) {
            PG8_LDB(B0, 0, 0); PG8_LDB(B1, 0, 1); PG8_SCHED; PG8_LDA(At, 0, 0); PG8_STAGE(PG8_SA(1, 1), a1 + hstep, voffA);
            PG8_WAIT_V(8); PG8_WAIT_L(0); PG8_BAR; PG8_MMA(0, 0, At, B0); PG8_MMA(0, 1, At, B1); PG8_BAR; PG8_SCHED;
            PG8_LDA(At, 0, 1); PG8_STAGE(PG8_SB(0, 0), b2, voffB); PG8_STAGE(PG8_SB(0, 1), b2 + hstep, voffB); PG8_STAGE(PG8_SA(0, 0), a2, voffA);
            PG8_WAIT_V(8); PG8_WAIT_L(0); PG8_BAR; PG8_MMA(1, 0, At, B0); PG8_MMA(1, 1, At, B1); PG8_BAR; PG8_SCHED;
            PG8_LDB(B0, 1, 0); PG8_LDB(B1, 1, 1); PG8_SCHED; PG8_LDA(At, 1, 0); PG8_STAGE(PG8_SA(0, 1), a2 + hstep, voffA);
            PG8_WAIT_V(8); PG8_WAIT_L(0); PG8_BAR; PG8_MMA(0, 0, At, B0); PG8_MMA(0, 1, At, B1); PG8_BAR; PG8_SCHED;
            PG8_LDA(At, 1, 1); PG8_STAGE(PG8_SB(1, 0), b3, voffB); PG8_STAGE(PG8_SB(1, 1), b3 + hstep, voffB); PG8_STAGE(PG8_SA(1, 0), a3, voffA);
            PG8_WAIT_V(8); PG8_WAIT_L(0); PG8_BAR; PG8_MMA(1, 0, At, B0); PG8_MMA(1, 1, At, B1); PG8_BAR; PG8_SCHED;
            } else {
            PG8_LDB(B0, 0, 0); PG8_SCHED; PG8_LDA(At, 0, 0); PG8_STAGE(PG8_SA(1, 1), a1 + hstep, voffA);
            PG8_WAIT_L(8); PG8_BAR; PG8_WAIT_L(0); PG8_MMA(0, 0, At, B0); PG8_BAR; PG8_SCHED;
            PG8_LDB(B1, 0, 1); PG8_STAGE(PG8_SB(0, 0), b2, voffB);
            PG8_BAR; PG8_WAIT_L(0); PG8_MMA(0, 1, At, B1); PG8_BAR;
            PG8_LDA(At, 0, 1); PG8_STAGE(PG8_SA(0, 0), a2, voffA);
            PG8_BAR; PG8_WAIT_L(0); PG8_MMA(1, 0, At, B0); PG8_BAR; PG8_SCHED;
            PG8_STAGE(PG8_SB(0, 1), b2 + hstep, voffB);
            PG8_WAIT_V(6); PG8_BAR; PG8_MMA(1, 1, At, B1); PG8_BAR;
            PG8_LDB(B0, 1, 0); PG8_SCHED; PG8_LDA(At, 1, 0); PG8_STAGE(PG8_SA(0, 1), a2 + hstep, voffA);
            PG8_WAIT_L(8); PG8_BAR; PG8_WAIT_L(0); PG8_MMA(0, 0, At, B0); PG8_BAR; PG8_SCHED;
            PG8_LDB(B1, 1, 1); PG8_STAGE(PG8_SB(1, 0), b3, voffB);
            PG8_BAR; PG8_WAIT_L(0); PG8_MMA(0, 1, At, B1); PG8_BAR;
            PG8_LDA(At, 1, 1); PG8_STAGE(PG8_SA(1, 0), a3, voffA);
            PG8_BAR; PG8_WAIT_L(0); PG8_MMA(1, 0, At, B0); PG8_BAR; PG8_SCHED;
            PG8_STAGE(PG8_SB(1, 1), b3 + hstep, voffB);
            PG8_WAIT_V(6); PG8_BAR; PG8_MMA(1, 1, At, B1); PG8_BAR;
            }
        }
        if constexpr (ALIGN_EPI) { if (wr == 0) PG8_BAR; }
        if constexpr (!Epi::AFTER_DRAIN) { E(acc, cur, wr, wc, fr, fq); S.done(cur); }
        if (!has_next) break;
#pragma unroll
        for (int a = 0; a < 2; ++a)
#pragma unroll
            for (int b = 0; b < 2; ++b)
#pragma unroll
                for (int m = 0; m < 4; ++m)
#pragma unroll
                    for (int n = 0; n < 2; ++n) acc[a][b][m][n] = (f32x4){0.f, 0.f, 0.f, 0.f};
        cur = nxt; cA = nA; cB = nB; ++ui;
        if constexpr (ALIGN_EPI) { if (wr == 1) PG8_BAR; }
    }
    PG8_WAIT_V(0);
    if constexpr (!ALIGN_EPI) { if (wr == 0) PG8_BAR; }
    PG8_BAR;
    if constexpr (Epi::AFTER_DRAIN) { E.fused(acc, cur, wr, wc, fr, fq, lds, wid, lane); S.done(cur); }
#undef PG8_SA
#undef PG8_SB
#undef PG8_STAGE
#undef PG8_LDA
#undef PG8_LDB
#undef PG8_MMA
#undef PG8_WAIT_V
#undef PG8_WAIT_L
#undef PG8_BAR
#undef PG8_SCHED
}
}

struct EpiProj8 {
    static constexpr bool PERM = true, AFTER_DRAIN = false;
    const Params* pp;
    DI void operator()(const f32x4 (&acc)[2][2][4][2], const pg8::Unit& u, int wr, int wc, int fr, int fq) const {
        const Params& p = *pp;
        const int colt = u.pn * 256, seg = colt >> 9;
        const bool isq = (seg == 0) || (seg == 4), isg = (seg == 3) || (seg == 7), iskv = !isq && !isg;
        const int oi = seg == 1 ? 0 : seg == 2 ? 1 : seg == 5 ? 2 : 3;
#pragma unroll
        for (int ai = 0; ai < 2; ++ai)
#pragma unroll
            for (int m = 0; m < 4; ++m) {
                const int R = u.pm * 256 + ai * 128 + wr * 64 + m * 16 + fr;
                float* fo = nullptr;
                if (iskv) {
                    if (R < ROWS_P) { const int b = R / LPAD, t = R - b * LPAD; if (t < LP) fo = p.out + O_PAK + oi * PKV_SZ + ((size_t)b * LP + t) * 512 - seg * 512; }
                    else fo = p.out + O_SAK + oi * SKV_SZ + (size_t)(R - ROWS_P) * 512 - seg * 512;
                }
                bf16_t* uo = p.u + (size_t)R * NU;
#pragma unroll
                for (int bj = 0; bj < 2; ++bj) {
                    const int n = colt + bj * 128 + wc * 32 + 8 * fq;
                    f32x4 v0 = acc[ai][bj][m][0], v1 = acc[ai][bj][m][1];
                    if (fo) { *(f32x4*)(fo + n) = v0; *(f32x4*)(fo + n + 4) = v1; }
                    if (isq) { v0 = v0 * QSCALE; v1 = v1 * QSCALE; }
                    else if (isg) {
#pragma unroll
                        for (int j = 0; j < 4; ++j) { v0[j] = v0[j] / (1.0f + __expf(-v0[j])); v1[j] = v1[j] / (1.0f + __expf(-v1[j])); }
                    }
                    *(u32x4*)(uo + n) = (u32x4){pk2(v0[0], v0[1]), pk2(v0[2], v0[3]), pk2(v1[0], v1[1]), pk2(v1[2], v1[3])};
                }
            }
    }
};

struct EpiOut8 {
    static constexpr bool PERM = true, AFTER_DRAIN = false;
    const Params* pp;
    DI void operator()(const f32x4 (&acc)[2][2][4][2], const pg8::Unit& u, int wr, int wc, int fr, int fq) const {
        const Params& p = *pp;
        const int colt = u.pn * 256;
#pragma unroll
        for (int ai = 0; ai < 2; ++ai)
#pragma unroll
            for (int m = 0; m < 4; ++m) {
                const int R = u.pm * 256 + ai * 128 + wr * 64 + m * 16 + fr;
                const float* xs = nullptr; float* yd = nullptr;
                if (R < ROWS_P) { const int b = R / LPAD, t = R - b * LPAD; if (t >= NMETA && t < LP) { const size_t idx = ((size_t)b * SEQ + t - NMETA) * DM; xs = p.x_prompt + idx; yd = p.out + O_YP + idx; } }
                else { const size_t idx = (size_t)(R - ROWS_P) * DM; xs = p.x_sample + idx; yd = p.out + O_YS + idx; }
                float ss = 0.f;
                if (xs) {
#pragma unroll
                    for (int bj = 0; bj < 2; ++bj) {
                        const int n = colt + bj * 128 + wc * 32 + 8 * fq;
                        const f32x4 x0 = *(const f32x4*)(xs + n), x1 = *(const f32x4*)(xs + n + 4);
                        const f32x4 h0 = x0 + acc[ai][bj][m][0], h1 = x1 + acc[ai][bj][m][1];
                        *(f32x4*)(yd + n) = h0; *(f32x4*)(yd + n + 4) = h1;
                        ss += h0[0] * h0[0] + h0[1] * h0[1] + h0[2] * h0[2] + h0[3] * h0[3] + h1[0] * h1[0] + h1[1] * h1[1] + h1[2] * h1[2] + h1[3] * h1[3];
                    }
                }
                ss += __shfl_xor(ss, 16); ss += __shfl_xor(ss, 32);
                if (xs && fq == 0) atomicAdd(p.rowss + R, ss);
            }
    }
};

DI void scan_unit(const Params& p, int su) {
    const int lane = threadIdx.x & 63, wave = threadIdx.x >> 6;
    const int seq = su * NW + wave;
    const int e0 = lane * 65;
    if (seq < 32) {
        const int b = seq >> 3, h = seq & 7;
        const float* src = p.out + O_PBL + (size_t)b * LP * 8 + h;
        float* dst = p.c2p + (size_t)seq * LPAD;
        float s = 0.f;
        for (int i = 0; i < 65; ++i) { const int e = e0 + i; if (e < LP) s += src[(size_t)e * 8]; }
        float incl = s;
#pragma unroll
        for (int o = 1; o < 64; o <<= 1) { const float t = __shfl_up(incl, o); if (lane >= o) incl += t; }
        float run = incl - s;
        for (int i = 0; i < 65; ++i) { const int e = e0 + i; if (e < LP) { run += src[(size_t)e * 8]; dst[e] = run * LOG2E; } else dst[e] = 0.f; }
    } else {
        const int sq = seq - 32, bb = sq >> 3, h = sq & 7;
        const float* src0 = p.cbl + (size_t)bb * PAST * 8 + h;
        const float* src1 = p.out + O_SBL + (size_t)bb * DSQ * 8 + h;
        float* dst = p.c2s + (size_t)sq * LSK;
        float s = 0.f;
        for (int i = 0; i < 65; ++i) { const int e = e0 + i; if (e < PAST) s += src0[(size_t)e * 8]; else if (e < LSK) s += src1[(size_t)(e - PAST) * 8]; }
        float incl = s;
#pragma unroll
        for (int o = 1; o < 64; o <<= 1) { const float t = __shfl_up(incl, o); if (lane >= o) incl += t; }
        float run = incl - s;
        for (int i = 0; i < 65; ++i) {
            const int e = e0 + i;
            if (e < LSK) { run += (e < PAST) ? src0[(size_t)e * 8] : src1[(size_t)(e - PAST) * 8]; dst[e] = run * LOG2E; }
        }
    }
}

struct AttnState { f32x16 o0, o1; float m, l; };

template <int MODE>
DI void attn_subtile(LDS_AS const char* Kl, LDS_AS const char* Vl, LDS_AS const char* biasl, const bf16x8 (&q)[4], AttnState& st, int kpos0, int qpos, bool need_mask, int lane) {
    const int l31 = lane & 31, hh = lane >> 5;
    f32x16 s;
    if (MODE == 1) {
#pragma unroll
        for (int g = 0; g < 4; ++g) { const f32x4 bv = *(LDS_AS const f32x4*)(biasl + (8 * g + 4 * hh) * 4); s[4 * g] = bv[0]; s[4 * g + 1] = bv[1]; s[4 * g + 2] = bv[2]; s[4 * g + 3] = bv[3]; }
    } else {
#pragma unroll
        for (int i = 0; i < 16; ++i) s[i] = 0.f;
    }
#pragma unroll
    for (int stp = 0; stp < 4; ++stp) { const bf16x8 kf = *(LDS_AS const bf16x8*)(Kl + l31 * 144 + (2 * stp + hh) * 16); s = MFMA(kf, q[stp], s); }
    if (MODE == 1) {
        if (need_mask) {
#pragma unroll
            for (int i = 0; i < 16; ++i) if (kpos0 + crow(i, hh) > qpos) s[i] = -INFINITY;
        }
        float mx = s[0];
#pragma unroll
        for (int i = 1; i < 16; ++i) mx = fmaxf(mx, s[i]);
        mx = fmaxf(mx, __shfl_xor(mx, 32));
        const float mn = fmaxf(st.m, mx);
        if (__any(mn > st.m)) { const float a = __builtin_amdgcn_exp2f(st.m - mn); st.o0 = st.o0 * a; st.o1 = st.o1 * a; st.l *= a; }
        st.m = mn;
        float ps = 0.f;
#pragma unroll
        for (int i = 0; i < 16; ++i) { s[i] = __builtin_amdgcn_exp2f(s[i] - mn); ps += s[i]; }
        st.l += ps;
    } else {
        f32x16 lk;
#pragma unroll
        for (int i = 0; i < 16; ++i) {
            const float z = s[i];
            const float e = __builtin_amdgcn_exp2f(-fabsf(z));
            const float sp = __builtin_amdgcn_logf(1.0f + e);
            float lkv = -fmaxf(z, 0.f) - sp;
            float lsv = z + lkv;
            if (need_mask && (kpos0 + crow(i, hh) >= qpos)) { lkv = 0.f; lsv = -INFINITY; }
            lk[i] = lkv; s[i] = lsv;
        }
        float tot[4], suf1[4], suf0[4];
#pragma unroll
        for (int g = 0; g < 4; ++g) { suf1[g] = lk[4 * g + 3] + lk[4 * g + 2]; suf0[g] = suf1[g] + lk[4 * g + 1]; tot[g] = suf0[g] + lk[4 * g]; }
        float pb[4], cs[4];
#pragma unroll
        for (int g = 0; g < 4; ++g) { pb[g] = __shfl_xor(tot[g], 32); cs[g] = tot[g] + pb[g]; }
        const float S3 = 0.f, S2 = cs[3], S1 = S2 + cs[2], S0 = S1 + cs[1], total = S0 + cs[0];
        const float Sg[4] = {S0, S1, S2, S3};
#pragma unroll
        for (int g = 0; g < 4; ++g) {
            const float base = st.l + Sg[g] + (hh == 0 ? pb[g] : 0.f);
            s[4 * g + 3] = __builtin_amdgcn_exp2f(s[4 * g + 3] + base);
            s[4 * g + 2] = __builtin_amdgcn_exp2f(s[4 * g + 2] + (base + lk[4 * g + 3]));
            s[4 * g + 1] = __builtin_amdgcn_exp2f(s[4 * g + 1] + (base + suf1[g]));
            s[4 * g + 0] = __builtin_amdgcn_exp2f(s[4 * g + 0] + (base + suf0[g]));
        }
        st.l += total;
    }
    bf16x8 pf[2];
#pragma unroll
    for (int s2 = 0; s2 < 2; ++s2) {
        u32x4 w;
        w[0] = pk2(s[8 * s2 + 0], s[8 * s2 + 1]); w[1] = pk2(s[8 * s2 + 2], s[8 * s2 + 3]);
        w[2] = pk2(s[8 * s2 + 4], s[8 * s2 + 5]); w[3] = pk2(s[8 * s2 + 6], s[8 * s2 + 7]);
        pf[s2] = __builtin_bit_cast(bf16x8, w);
    }
    const int i16 = lane & 15, qq = i16 >> 2, pp = i16 & 3, gg = (lane >> 4) & 1;
#pragma unroll
    for (int s2 = 0; s2 < 2; ++s2)
#pragma unroll
        for (int dt = 0; dt < 2; ++dt) {
            LDS_AS const char* a_lo = Vl + (16 * s2 + 4 * hh + qq) * 144 + (32 * dt + 16 * gg + 4 * pp) * 2;
            const s16x4 lo = __builtin_amdgcn_ds_read_tr16_b64_v4i16((LDS_AS s16x4*)a_lo);
            const s16x4 hi = __builtin_amdgcn_ds_read_tr16_b64_v4i16((LDS_AS s16x4*)(a_lo + 8 * 144));
            const bf16x8 vf = __builtin_shufflevector(lo, hi, 0, 1, 2, 3, 4, 5, 6, 7);
            if (dt == 0) st.o0 = MFMA(vf, pf[s2], st.o0); else st.o1 = MFMA(vf, pf[s2], st.o1);
        }
}

DI void fox_softmax32(f32x16& s, AttnState& st, bf16x8 (&pf)[2]) {
    float mx = max2f(s[0], s[1]);
#pragma unroll
    for (int i = 2; i < 16; i += 2) mx = max3f(mx, s[i], s[i + 1]);
    mx = max2f(mx, __shfl_xor(mx, 32));
    const float mn = max2f(st.m, mx);
    if (__any(mn > st.m)) { const float a = __builtin_amdgcn_exp2f(st.m - mn); st.o0 = st.o0 * a; st.o1 = st.o1 * a; st.l *= a; }
    st.m = mn;
    const f32x2 mn2 = {mn, mn};
    f32x2 acc2 = {0.f, 0.f};
#pragma unroll
    for (int i = 0; i < 16; i += 2) {
        f32x2 t = {s[i], s[i + 1]};
        t = t - mn2;
        t[0] = __builtin_amdgcn_exp2f(t[0]); t[1] = __builtin_amdgcn_exp2f(t[1]);
        acc2 = acc2 + t;
        s[i] = t[0]; s[i + 1] = t[1];
    }
    st.l += acc2[0] + acc2[1];
#pragma unroll
    for (int s2 = 0; s2 < 2; ++s2) {
        u32x4 w;
        w[0] = pk2(s[8 * s2 + 0], s[8 * s2 + 1]); w[1] = pk2(s[8 * s2 + 2], s[8 * s2 + 3]); w[2] = pk2(s[8 * s2 + 4], s[8 * s2 + 5]); w[3] = pk2(s[8 * s2 + 6], s[8 * s2 + 7]);
        pf[s2] = __builtin_bit_cast(bf16x8, w);
    }
}
DI void fox_pv32(LDS_AS const char* Vl, const bf16x8 (&pf)[2], AttnState& st, int lane) {
    const int hh = lane >> 5, i16 = lane & 15, qq = i16 >> 2, pp = i16 & 3, gg = (lane >> 4) & 1;
#pragma unroll
    for (int s2 = 0; s2 < 2; ++s2)
#pragma unroll
        for (int dt = 0; dt < 2; ++dt) {
            LDS_AS const char* a_lo = Vl + (16 * s2 + 4 * hh + qq) * 144 + (32 * dt + 16 * gg + 4 * pp) * 2;
            const s16x4 lo = __builtin_amdgcn_ds_read_tr16_b64_v4i16((LDS_AS s16x4*)a_lo);
            const s16x4 hi = __builtin_amdgcn_ds_read_tr16_b64_v4i16((LDS_AS s16x4*)(a_lo + 8 * 144));
            const bf16x8 vf = __builtin_shufflevector(lo, hi, 0, 1, 2, 3, 4, 5, 6, 7);
            if (dt == 0) st.o0 = MFMA(vf, pf[s2], st.o0); else st.o1 = MFMA(vf, pf[s2], st.o1);
        }
}
DI void attn_tile64_fox(LDS_AS const char* Kl, LDS_AS const char* Vl, LDS_AS const char* biasl, const bf16x8 (&q)[4], AttnState& st, int lane) {
    const int l31 = lane & 31, hh = lane >> 5;
    f32x16 s0, s1;
#pragma unroll
    for (int g = 0; g < 4; ++g) {
        const f32x4 b0 = *(LDS_AS const f32x4*)(biasl + (8 * g + 4 * hh) * 4);
        const f32x4 b1 = *(LDS_AS const f32x4*)(biasl + 128 + (8 * g + 4 * hh) * 4);
        s0[4 * g] = b0[0]; s0[4 * g + 1] = b0[1]; s0[4 * g + 2] = b0[2]; s0[4 * g + 3] = b0[3];
        s1[4 * g] = b1[0]; s1[4 * g + 1] = b1[1]; s1[4 * g + 2] = b1[2]; s1[4 * g + 3] = b1[3];
    }
    bf16x8 k0[4], k1[4];
#pragma unroll
    for (int stp = 0; stp < 4; ++stp) {
        k1[stp] = *(LDS_AS const bf16x8*)(Kl + 32 * 144 + l31 * 144 + (2 * stp + hh) * 16);
        k0[stp] = *(LDS_AS const bf16x8*)(Kl + l31 * 144 + (2 * stp + hh) * 16);
    }
#pragma unroll
    for (int stp = 0; stp < 4; ++stp) s1 = MFMA(k1[stp], q[stp], s1);
#pragma unroll
    for (int stp = 0; stp < 4; ++stp) s0 = MFMA(k0[stp], q[stp], s0);
    __builtin_amdgcn_sched_barrier(0);
    bf16x8 pf1[2], pf0[2];
    fox_softmax32(s1, st, pf1);
    __builtin_amdgcn_sched_barrier(0);
    fox_pv32(Vl + 32 * 144, pf1, st, lane);
    __builtin_amdgcn_sched_barrier(0);
    fox_softmax32(s0, st, pf0);
    __builtin_amdgcn_sched_barrier(0);
    fox_pv32(Vl, pf0, st, lane);
}

DI void store_gated(const AttnState& st, const bf16_t* sg, bf16_t* mo, int hh) {
#pragma unroll
    for (int dt = 0; dt < 2; ++dt)
#pragma unroll
        for (int g = 0; g < 4; ++g) {
            const int d = 32 * dt + 8 * g + 4 * hh;
            const u32x2 gv = *(const u32x2*)(sg + d);
            const f32x16& o = dt == 0 ? st.o0 : st.o1;
            const float a0 = o[4 * g] * bflo(gv[0]), a1 = o[4 * g + 1] * bfhi(gv[0]), a2 = o[4 * g + 2] * bflo(gv[1]), a3 = o[4 * g + 3] * bfhi(gv[1]);
            *(u32x2*)(mo + d) = (u32x2){pk2(a0, a1), pk2(a2, a3)};
        }
}

constexpr int PSTG = 18688;

template <int MODE>
DI void prompt_unit(const Params& p, int b, int h, int qt, char* smem) {
    int tid_ = threadIdx.x; asm volatile("" : "+v"(tid_));
    const int tid = tid_, lane = tid & 63, wave = tid >> 6, l31 = lane & 31, hh = lane >> 5;
    LDS_AS char* lb = (LDS_AS char*)smem;
    const int t0 = qt * 256, wq0 = t0 + 32 * wave;
    const int qpos = wq0 + l31;
    const bool wave_valid = wq0 < LP;
    const int qcol = (MODE == 0 ? 0 : 2048) + h * 64, kcol = qcol + 512, vcol = qcol + 1024, gcol = qcol + 1536;
    const size_t rowb = (size_t)b * LPAD;
    bf16x8 q[4];
    {
        const int qr = qpos < LPAD ? qpos : LPAD - 1;
        const bf16_t* qp = p.u + (rowb + qr) * NU + qcol + 8 * hh;
#pragma unroll
        for (int s = 0; s < 4; ++s) q[s] = *(const bf16x8*)(qp + 16 * s);
    }
    AttnState st;
#pragma unroll
    for (int i = 0; i < 16; ++i) { st.o0[i] = 0.f; st.o1[i] = 0.f; }
    st.m = -1e30f; st.l = 0.f;
    const int kt_max = (4 * qt + 3) < 64 ? (4 * qt + 3) : 64;
    const float* cb = p.c2p + (size_t)(b * 8 + h) * LPAD;
    float cref = 0.f;
    if (MODE == 1) cref = cb[t0 < LP ? t0 : LP - 1];
    u32x4 rk, rv; float rbias = 0.f;
    const int r0 = tid >> 3, c0 = tid & 7;
    auto pload = [&](int kt) {
        const bf16_t* kb = p.u + (rowb + (size_t)kt * 64 + r0) * NU + c0 * 8;
        rk = *(const u32x4*)(kb + kcol); rv = *(const u32x4*)(kb + vcol);
        if (MODE == 1 && tid < 64) rbias = cref - cb[kt * 64 + tid];
    };
    auto pstore = [&](int sg) {
        LDS_AS char* base = lb + sg * PSTG + r0 * 144 + c0 * 16;
        *(LDS_AS u32x4*)(base) = rk; *(LDS_AS u32x4*)(base + 9216) = rv;
        if (MODE == 1 && tid < 64) *(LDS_AS float*)(lb + sg * PSTG + 18432 + tid * 4) = rbias;
    };
    __syncthreads();
    pload(kt_max); pstore(0);
    __syncthreads();
    int stg = 0;
    bool wdone = !wave_valid;
    for (int kt = kt_max; kt >= 0; --kt) {
        if (kt > 0) pload(kt - 1);
        if (!wdone) {
            LDS_AS const char* sb = lb + stg * PSTG;
            if (MODE == 1 && kt * 64 + 63 < wq0) attn_tile64_fox(sb, sb + 9216, sb + 18432, q, st, lane);
            else
#pragma unroll
            for (int sub = 1; sub >= 0; --sub) {
                const int kp0 = kt * 64 + sub * 32;
                if (kp0 <= wq0 + 31) {
                    const bool nm = (kp0 + 31 >= wq0);
                    attn_subtile<MODE>(sb + sub * 32 * 144, sb + 9216 + sub * 32 * 144, sb + 18432 + sub * 128, q, st, kp0, qpos, nm, lane);
                }
            }
            if (MODE == 0) wdone = __all(st.l < -SB_THRESH);
        }
        if (kt > 0) pstore(stg ^ 1);
        if (MODE == 0) { if (__syncthreads_and(wdone ? 1 : 0)) break; }
        else __syncthreads();
        stg ^= 1;
    }
    if (MODE == 1) { const float lt = st.l + __shfl_xor(st.l, 32); const float inv = 1.0f / lt; st.o0 = st.o0 * inv; st.o1 = st.o1 * inv; }
    if (wave_valid && qpos < LP) store_gated(st, p.u + (rowb + qpos) * NU + gcol, p.mix + (rowb + qpos) * DM + (MODE == 0 ? 0 : 512) + h * 64, hh);
}

DI void prompt_sb_unit(const Params& p, int b, int h, int qt, char* smem) {
    int tid_ = threadIdx.x; asm volatile("" : "+v"(tid_));
    const int tid = tid_, lane = tid & 63, wave = tid >> 6, l31 = lane & 31, hh = lane >> 5;
    LDS_AS char* lb = (LDS_AS char*)smem + wave * 9216;
    const int wq0 = qt * 256 + 32 * wave, qpos = wq0 + l31;
    const int qcol = h * 64, kcol = qcol + 512, vcol = qcol + 1024, gcol = qcol + 1536;
    const size_t rowb = (size_t)b * LPAD;
    __syncthreads();
    if (wq0 < LP) {
        bf16x8 q[4];
        {
            const bf16_t* qp = p.u + (rowb + qpos) * NU + qcol + 8 * hh;
#pragma unroll
            for (int s = 0; s < 4; ++s) q[s] = *(const bf16x8*)(qp + 16 * s);
        }
        AttnState st;
#pragma unroll
        for (int i = 0; i < 16; ++i) { st.o0[i] = 0.f; st.o1[i] = 0.f; }
        st.m = -1e30f; st.l = 0.f;
        u32x4 rk[4], rv[4];
        const int r0 = lane >> 3, c0 = lane & 7;
        const bf16_t* ub = p.u + (rowb + r0) * NU + c0 * 8;
        int kp = wq0;
        {
            const bf16_t* kb = ub + (size_t)kp * NU;
#pragma unroll
            for (int i = 0; i < 4; ++i) { rk[i] = *(const u32x4*)(kb + (size_t)(8 * i) * NU + kcol); rv[i] = *(const u32x4*)(kb + (size_t)(8 * i) * NU + vcol); }
        }
        for (;;) {
            asm volatile("s_waitcnt lgkmcnt(0)" ::: "memory");
#pragma unroll
            for (int i = 0; i < 4; ++i) { *(LDS_AS u32x4*)(lb + (r0 + 8 * i) * 144 + c0 * 16) = rk[i]; *(LDS_AS u32x4*)(lb + 4608 + (r0 + 8 * i) * 144 + c0 * 16) = rv[i]; }
            const int kn = kp - 32;
            if (kn >= 0) {
                const bf16_t* kb = ub + (size_t)kn * NU;
#pragma unroll
                for (int i = 0; i < 4; ++i) { rk[i] = *(const u32x4*)(kb + (size_t)(8 * i) * NU + kcol); rv[i] = *(const u32x4*)(kb + (size_t)(8 * i) * NU + vcol); }
            }
            asm volatile("s_waitcnt lgkmcnt(0)" ::: "memory");
            attn_subtile<0>(lb, lb + 4608, lb, q, st, kp, qpos, kp == wq0, lane);
            if (kn < 0 || __all(st.l < -SB_THRESH)) break;
            kp = kn;
        }
        if (qpos < LP) store_gated(st, p.u + (rowb + qpos) * NU + gcol, p.mix + (rowb + qpos) * DM + h * 64, hh);
    }
}

template <int MODE>
DI void sample_unit(const Params& p, int bb, int split, char* smem, int cq = 0) {
    int tid_ = threadIdx.x; asm volatile("" : "+v"(tid_));
    const int tid = tid_, lane = tid & 63, wave = tid >> 6, l31 = lane & 31, hh = lane >> 5;
    LDS_AS char* lb = (LDS_AS char*)smem;
    const int h = wave;
    const int qpos = PAST + l31;
    const size_t Rq = (size_t)ROWS_P + bb * 32 + l31;
    const int segb = (MODE == 0 ? 0 : 2048);
    const int qcol = segb + h * 64, gcol = qcol + 1536;
    bf16x8 q[4];
    {
        const bf16_t* qp = p.u + Rq * NU + qcol + 8 * hh;
#pragma unroll
        for (int s = 0; s < 4; ++s) q[s] = *(const bf16x8*)(qp + 16 * s);
    }
    AttnState st;
#pragma unroll
    for (int i = 0; i < 16; ++i) { st.o0[i] = 0.f; st.o1[i] = 0.f; }
    st.m = -1e30f; st.l = 0.f;
    const float* ck = (MODE == 0 ? p.cak : p.cbk) + (size_t)bb * PAST * 512;
    const float* cv = (MODE == 0 ? p.cav : p.cbv) + (size_t)bb * PAST * 512;
    const int ntc = (MODE == 1 ? (PAST / NSPLIT / 32) : 128), kbase = (MODE == 1 ? (PAST / NSPLIT) * split : 0);
    const bool has_new = (MODE == 0) || (split == NSPLIT - 1);
    const float* cseq = p.c2s + (size_t)(bb * 8 + ((tid >> 5) & 7)) * LSK;
    float cref = 0.f;
    if (MODE == 1 && tid < 256) cref = cseq[PAST];
    constexpr int KOFF = 0, VOFF = 36864, BOFF = 73728, HSTR = 4608;
    bool wdone = false, alldone = false;
    if (has_new) {
        __syncthreads();
        const bf16_t* kb = p.u + ((size_t)ROWS_P + bb * 32) * NU + segb + 512;
#pragma unroll
        for (int i = 0; i < 4; ++i) {
            const int id = tid + 512 * i, r = id >> 6, c = id & 63, hd = c >> 3, d = (c & 7) * 8;
            const u32x4 kx = *(const u32x4*)(kb + (size_t)r * NU + c * 8);
            const u32x4 vx = *(const u32x4*)(kb + (size_t)r * NU + 512 + c * 8);
            *(LDS_AS u32x4*)(lb + KOFF + hd * HSTR + r * 144 + d * 2) = kx;
            *(LDS_AS u32x4*)(lb + VOFF + hd * HSTR + r * 144 + d * 2) = vx;
        }
        if (MODE == 1 && tid < 256) *(LDS_AS float*)(lb + BOFF + tid * 4) = cref - cseq[PAST + (tid & 31)];
        __syncthreads();
        attn_subtile<MODE>(lb + KOFF + wave * HSTR, lb + VOFF + wave * HSTR, lb + BOFF + wave * 128, q, st, PAST, qpos, true, lane);
        if (MODE == 0) { wdone = __all(st.l < -SB_THRESH); alldone = __syncthreads_and(wdone ? 1 : 0) != 0; }
    }
    if (!alldone) {
        f32x4 tk[8], tv[8]; float tb = 0.f;
        const int rot = (MODE == 1) ? ((bb * NSPLIT + split) * 5) % ntc : 0;
        {
            const int t0i = (ntc - 1 + rot) % ntc;
            const float* kg = ck + (size_t)(kbase + 32 * t0i) * 512;
            const float* vg = cv + (size_t)(kbase + 32 * t0i) * 512;
            if (MODE == 1 && tid < 256) tb = cseq[kbase + 32 * t0i + (tid & 31)];
#pragma unroll
            for (int i = 0; i < 8; ++i) { const int id = tid + 512 * i; tk[i] = __builtin_nontemporal_load((const f32x4*)(kg + (size_t)id * 4)); tv[i] = __builtin_nontemporal_load((const f32x4*)(vg + (size_t)id * 4)); }
        }
        for (int it = ntc - 1; it >= 0; --it) {
            const int kpos0 = kbase + 32 * ((it + rot) % ntc);
            const int kposn = kbase + 32 * ((it - 1 + rot + ntc) % ntc);
            __syncthreads();
#pragma unroll
            for (int i = 0; i < 8; ++i) {
                const int id = tid + 512 * i, r = id >> 7, c4 = id & 127, hd = c4 >> 4, d = (c4 & 15) * 4;
                *(LDS_AS u32x2*)(lb + KOFF + hd * HSTR + r * 144 + d * 2) = (u32x2){pk2(tk[i][0], tk[i][1]), pk2(tk[i][2], tk[i][3])};
                *(LDS_AS u32x2*)(lb + VOFF + hd * HSTR + r * 144 + d * 2) = (u32x2){pk2(tv[i][0], tv[i][1]), pk2(tv[i][2], tv[i][3])};
            }
            if (MODE == 1 && tid < 256) *(LDS_AS float*)(lb + BOFF + tid * 4) = cref - tb;
            if (it > 0) {
                const float* kg = ck + (size_t)kposn * 512;
                const float* vg = cv + (size_t)kposn * 512;
                if (MODE == 1 && tid < 256) tb = cseq[kposn + (tid & 31)];
#pragma unroll
                for (int i = 0; i < 8; ++i) { const int id = tid + 512 * i; tk[i] = __builtin_nontemporal_load((const f32x4*)(kg + (size_t)id * 4)); tv[i] = __builtin_nontemporal_load((const f32x4*)(vg + (size_t)id * 4)); }
            }
            __builtin_amdgcn_sched_barrier(0);
            __syncthreads();
            if (!wdone) {
                attn_subtile<MODE>(lb + KOFF + wave * HSTR, lb + VOFF + wave * HSTR, lb + BOFF + wave * 128, q, st, kpos0, qpos, false, lane);
                if (MODE == 0) wdone = __all(st.l < -SB_THRESH);
            }
            if (MODE == 0) { if (__syncthreads_and(wdone ? 1 : 0)) break; }
        }
    }
    if (MODE == 0) {
        store_gated(st, p.u + Rq * NU + gcol, p.mix + Rq * DM + h * 64, hh);
        return;
    }
    {
        const float lt = st.l + __shfl_xor(st.l, 32);
        float* pp = p.part + ((((size_t)bb * NSPLIT + split) * 8) + wave) * PART_STRIDE;
        if (hh == 0) { pp[l31] = st.m; pp[32 + l31] = lt; }
#pragma unroll
        for (int dt = 0; dt < 2; ++dt)
#pragma unroll
            for (int g = 0; g < 4; ++g) {
                const int d = 32 * dt + 8 * g + 4 * hh;
                const f32x16& o = dt == 0 ? st.o0 : st.o1;
                *(f32x4*)(pp + 64 + l31 * 64 + d) = (f32x4){o[4 * g], o[4 * g + 1], o[4 * g + 2], o[4 * g + 3]};
            }
    }
    asm volatile("s_waitcnt vmcnt(0)" ::: "memory");
    __syncthreads();
    LDS_AS int* sflag = (LDS_AS int*)((LDS_AS char*)smem + SM_UNIT_OFF + 4);
    if (tid == 0) {
        __builtin_amdgcn_fence(__ATOMIC_RELEASE, "agent");
        asm volatile("s_waitcnt vmcnt(0)" ::: "memory");
        const unsigned old = __hip_atomic_fetch_add(p.ctrl + cq + 8 + bb, 1u, __ATOMIC_RELAXED, __HIP_MEMORY_SCOPE_AGENT);
        const int lastf = (old == (unsigned)(NSPLIT - 1)) ? 1 : 0;
        if (lastf) { __builtin_amdgcn_fence(__ATOMIC_ACQUIRE, "agent"); asm volatile("s_waitcnt vmcnt(0)" ::: "memory"); }
        *sflag = lastf;
    }
    __syncthreads();
    const int last = *sflag;
    if (!last) return;
    {
        const int hd = tid >> 6, qi = (tid & 63) >> 1, d0 = (tid & 1) * 32;
        const float* pb = p.part + (((size_t)bb * NSPLIT) * 8 + hd) * PART_STRIDE;
        float M = -1e30f;
#pragma unroll 1
        for (int s = 0; s < NSPLIT; ++s) M = fmaxf(M, __builtin_nontemporal_load(pb + (size_t)s * 8 * PART_STRIDE + qi));
        float L = 0.f; float o[32];
#pragma unroll
        for (int j = 0; j < 32; ++j) o[j] = 0.f;
#pragma unroll 1
        for (int s = 0; s < NSPLIT; ++s) {
            const float* ps = pb + (size_t)s * 8 * PART_STRIDE;
            const float w = __builtin_amdgcn_exp2f(__builtin_nontemporal_load(ps + qi) - M);
            L += w * __builtin_nontemporal_load(ps + 32 + qi);
#pragma unroll
            for (int j = 0; j < 8; ++j) { const f32x4 v = *(const f32x4*)(ps + 64 + qi * 64 + d0 + 4 * j); o[4 * j] += w * v[0]; o[4 * j + 1] += w * v[1]; o[4 * j + 2] += w * v[2]; o[4 * j + 3] += w * v[3]; }
        }
        const float inv = 1.0f / L;
        const size_t R = (size_t)ROWS_P + bb * 32 + qi;
        const int hcol = hd * 64 + d0;
        const bf16_t* sg = p.u + R * NU + 3584 + hcol;
        bf16_t* mo = p.mix + R * DM + 512 + hcol;
#pragma unroll
        for (int j = 0; j < 8; ++j) {
            const u32x2 gv = *(const u32x2*)(sg + 4 * j);
            *(u32x2*)(mo + 4 * j) = (u32x2){pk2(o[4 * j] * inv * bflo(gv[0]), o[4 * j + 1] * inv * bfhi(gv[0])), pk2(o[4 * j + 2] * inv * bflo(gv[1]), o[4 * j + 3] * inv * bfhi(gv[1]))};
        }
    }
}

constexpr int NU_SF = DB * NSPLIT, NU_PF = 32 * 17, NU_SS = DB, NU_PS = 32 * 17;

__global__ void __launch_bounds__(512, 2) hymba_mega(Params p) {
    extern __shared__ __attribute__((aligned(16))) char smem[];
    const int tid = threadIdx.x;
    volatile LDS_AS unsigned* xbst = (volatile LDS_AS unsigned*)((LDS_AS char*)smem + 131072);
    if (tid == 0) { xbst[0] = 0u; xbst[1] = 0u; xbst[2] = 0u; xbst[3] = 0u; }
    __syncthreads();
    const XcdBarrier xb = xcd_barrier_post(p.bar, xbst);

    phase0(p, smem);
    xcd_barrier(xb);

    {
        const int su = (int)gridDim.x - 1 - (int)blockIdx.x;
        if (su < 20) scan_unit(p, su);
        __syncthreads();
        pg8::StaticOrder S; S.init(NR, 4096, (int)gridDim.x, (int)blockIdx.x);
        const pg8::Gemm g{p.xn, p.wtin, NR, 4096, DM};
        const EpiProj8 E{&p};
        pg8::gemm_phase<EpiProj8, pg8::StaticOrder, true, true>((PG8_LAS unsigned char*)smem, g, S, E);
        xcd_barrier(xb);
#if DUP_P1
        pg8::gemm_phase<EpiProj8, pg8::StaticOrder, true, true>((PG8_LAS unsigned char*)smem, g, S, E);
        xcd_barrier(xb);
#endif
    }

    for (int rep = 0; rep < 1 + DUP_P2; ++rep) {
        const int cq = rep * 64;
        LDS_AS int* sunit = (LDS_AS int*)((LDS_AS char*)smem + SM_UNIT_OFF);
#define QUEUE_LOOP(QI, NUNITS, BODY) \
        for (;;) { \
            __syncthreads(); \
            if (tid == 0) *sunit = (int)atomicAdd(p.ctrl + cq + (QI), 1u); \
            __syncthreads(); \
            const int u = *sunit; \
            if (u >= (NUNITS)) break; \
            BODY; \
        }
        const bool streamer = ((blockIdx.x >> 3) & 3) == 0;
        for (int ph = 0; ph < 4; ++ph) {
            const int qi = streamer ? (ph == 0 ? 0 : ph == 1 ? 2 : ph == 2 ? 1 : 3) : (ph == 0 ? 1 : ph == 1 ? 0 : ph == 2 ? 2 : 3);
            if (qi == 0) { QUEUE_LOOP(0, NU_SF, sample_unit<1>(p, u / NSPLIT, u % NSPLIT, smem, cq)) }
            else if (qi == 1) { QUEUE_LOOP(1, NU_PF, prompt_unit<1>(p, (u & 31) >> 3, u & 7, 16 - (u >> 5), smem)) }
            else if (qi == 2) { QUEUE_LOOP(2, NU_SS, sample_unit<0>(p, u, 0, smem)) }
            else { QUEUE_LOOP(3, NU_PS, prompt_sb_unit(p, (u & 31) >> 3, u & 7, 16 - (u >> 5), smem)) }
        }
        xcd_barrier(xb);
    }

    {
        pg8::StaticOrder S; S.init(NR, DM, (int)gridDim.x, (int)blockIdx.x);
        const pg8::Gemm g{p.mix, p.wtout, NR, DM, DM};
        const EpiOut8 E{&p};
        pg8::gemm_phase<EpiOut8, pg8::StaticOrder, true, true>((PG8_LAS unsigned char*)smem, g, S, E);
    }
    xcd_barrier(xb);

    {
        const int lane = tid & 63, wave = tid >> 6;
        auto row_dst = [&](int R) -> float* {
            if (R < ROWS_P) { const int b = R / LPAD, t = R - b * LPAD; if (t >= NMETA && t < LP) return p.out + O_YP + ((size_t)b * SEQ + t - NMETA) * DM; return nullptr; }
            return p.out + O_YS + (size_t)(R - ROWS_P) * DM;
        };
        f32x4 gq[4];
#pragma unroll
        for (int i = 0; i < 4; ++i) gq[i] = *(const f32x4*)(p.final_g + i * 256 + lane * 4);
        f32x4 vn[4]; float rn;
        {
            const int R0 = blockIdx.x * NW + wave;
            float* d0 = R0 < NR ? row_dst(R0) : nullptr; if (!d0) d0 = p.out + O_YS;
            rn = p.rowss[R0 < NR ? R0 : 0];
#pragma unroll
            for (int i = 0; i < 4; ++i) vn[i] = *(const f32x4*)(d0 + i * 256 + lane * 4);
        }
        for (int R = blockIdx.x * NW + wave; R < NR; R += gridDim.x * NW) {
            float* yd = row_dst(R);
            f32x4 v[4]; const float rs = rn;
#pragma unroll
            for (int i = 0; i < 4; ++i) v[i] = vn[i];
            {
                const int Rn = R + gridDim.x * NW;
                float* dn = Rn < NR ? row_dst(Rn) : nullptr; if (!dn) dn = p.out + O_YS;
                rn = p.rowss[Rn < NR ? Rn : 0];
#pragma unroll
                for (int i = 0; i < 4; ++i) vn[i] = *(const f32x4*)(dn + i * 256 + lane * 4);
            }
            if (!yd) continue;
            const float rstd = 1.0f / sqrtf(rs * (1.0f / 1024.0f) + EPS);
#pragma unroll
            for (int i = 0; i < 4; ++i) *(f32x4*)(yd + i * 256 + lane * 4) = v[i] * rstd * gq[i];
        }
    }
}

static inline size_t align_up(size_t x) { return (x + 255) & ~(size_t)255; }

extern "C" void kernel_launch(void* const* d_in, const int* in_sizes, int n_in, void* d_out, int out_size, void* d_ws, size_t ws_size, hipStream_t stream) {
    Params p{};
    p.x_prompt = (const float*)d_in[0]; p.x_sample = (const float*)d_in[1];
    p.cak = (const float*)d_in[2]; p.cav = (const float*)d_in[3]; p.cbk = (const float*)d_in[4]; p.cbv = (const float*)d_in[5]; p.cbl = (const float*)d_in[6];
    p.meta = (const float*)d_in[7]; p.norm_g = (const float*)d_in[8]; p.w_in = (const float*)d_in[9]; p.b_f = (const float*)d_in[10];
    p.w_out = (const float*)d_in[11]; p.final_g = (const float*)d_in[12];
    p.out = (float*)d_out;
    char* w = (char*)d_ws; size_t off = 0;
    p.ctrl = (unsigned*)(w + off); off = align_up(off + 4096);
    p.bar = (unsigned*)(w + off); off = align_up(off + XCD_BAR_WORDS * 4);
    p.rowss = (float*)(w + off); off = align_up(off + (size_t)NR * 4);
    p.wtin = (bf16_t*)(w + off); off = align_up(off + (size_t)4096 * DM * 2);
    p.wtout = (bf16_t*)(w + off); off = align_up(off + (size_t)DM * DM * 2);
    p.xn = (bf16_t*)(w + off); off = align_up(off + (size_t)NR * DM * 2);
    p.u = (bf16_t*)(w + off); off = align_up(off + (size_t)NR * NU * 2);
    p.mix = (bf16_t*)(w + off); off = align_up(off + (size_t)NR * DM * 2);
    p.c2p = (float*)(w + off); off = align_up(off + (size_t)32 * LPAD * 4);
    p.c2s = (float*)(w + off); off = align_up(off + (size_t)128 * LSK * 4);
    p.part = (float*)(w + off); off = align_up(off + (size_t)DB * NSPLIT * 8 * PART_STRIDE * 4);
    static int grid_blocks = 0;
    if (!grid_blocks) {
        int dev = 0, cus = 0, per_cu = 0;
        hipGetDevice(&dev);
        hipFuncSetAttribute((const void*)hymba_mega, hipFuncAttributeMaxDynamicSharedMemorySize, SMEM_BYTES);
        hipDeviceGetAttribute(&cus, hipDeviceAttributeMultiprocessorCount, dev);
        hipOccupancyMaxActiveBlocksPerMultiprocessor(&per_cu, hymba_mega, NT, SMEM_BYTES);
        if (per_cu > 1) per_cu = 1;
        grid_blocks = cus * per_cu;
        if (grid_blocks <= 0) grid_blocks = 256;
    }
    hipMemsetAsync(p.bar, 0, XCD_BAR_WORDS * 4, stream);
    void* args[] = {&p};
    hipError_t e = hipLaunchCooperativeKernel((void*)hymba_mega, dim3(grid_blocks), dim3(NT), args, SMEM_BYTES, stream);
    if (e != hipSuccess) fprintf(stderr, "cooperative launch failed: %s (grid %d)\n", hipGetErrorString(e), grid_blocks);
}
```

```cpp
#include <hip/hip_runtime.h>
#include <hip/hip_cooperative_groups.h>
#include <cstdio>
#include <cstdint>
namespace cg = cooperative_groups;

typedef unsigned short bf16_t;
typedef short bf16x8 __attribute__((ext_vector_type(8)));
typedef short s16x4 __attribute__((ext_vector_type(4)));
typedef float f32x16 __attribute__((ext_vector_type(16)));
typedef float f32x4 __attribute__((ext_vector_type(4)));
typedef float f32x2 __attribute__((ext_vector_type(2)));
typedef unsigned u32x4 __attribute__((ext_vector_type(4)));
typedef unsigned u32x2 __attribute__((ext_vector_type(2)));
typedef __bf16 bf16x2v __attribute__((ext_vector_type(2)));

#define DI __device__ __forceinline__
#define LDS_AS __attribute__((address_space(3)))
#define MFMA(a, b, c) __builtin_amdgcn_mfma_f32_32x32x16_bf16((a), (b), (c), 0, 0, 0)

constexpr int DM = 1024;
constexpr int NB = 4, SEQ = 4096, NMETA = 16, LP = 4112, LPAD = 4160;
constexpr int DB = 16, DSQ = 32, PAST = 4096, LSK = 4128;
constexpr int ROWS_P = NB * LPAD;
constexpr int ROWS_S = DB * DSQ;
constexpr int NR = ROWS_P + ROWS_S;
constexpr int INW = 4104;
constexpr int NU = 4096;
constexpr float EPS = 1e-6f;
constexpr float LOG2E = 1.4426950408889634f;
constexpr float QSCALE = 0.125f * LOG2E;
constexpr float SB_THRESH = 48.0f;

constexpr size_t O_YP = 0;
constexpr size_t O_YS = O_YP + (size_t)NB * SEQ * DM;
constexpr size_t PKV_SZ = (size_t)NB * LP * 512;
constexpr size_t SKV_SZ = (size_t)DB * DSQ * 512;
constexpr size_t O_PAK = O_YS + (size_t)DB * DSQ * DM;
constexpr size_t O_PBL = O_PAK + 4 * PKV_SZ;
constexpr size_t O_SAK = O_PBL + (size_t)NB * LP * 8;
constexpr size_t O_SBL = O_SAK + 4 * SKV_SZ;

#ifndef DUP_P1
#define DUP_P1 0
#endif
#ifndef DUP_P2
#define DUP_P2 0
#endif
constexpr int NT = 512, NW = 8;
constexpr int SMEM_BYTES = 131072 + 256;
constexpr int SM_UNIT_OFF = 131072 + 64;
constexpr int PART_STRIDE = 64 + 32 * 64;
constexpr int NSPLIT = 4;

struct Params {
    const float *x_prompt, *x_sample, *cak, *cav, *cbk, *cbv, *cbl, *meta, *norm_g, *w_in, *b_f, *w_out, *final_g;
    float* out;
    unsigned* ctrl; unsigned* bar; float* rowss; bf16_t *wtin, *wtout, *xn, *u, *mix; float *c2p, *c2s, *part;
};

DI unsigned pk2(float a, float b) { f32x2 v = {a, b}; bf16x2v r = __builtin_convertvector(v, bf16x2v); return __builtin_bit_cast(unsigned, r); }
DI float bflo(unsigned w) { return __uint_as_float(w << 16); }
DI float bfhi(unsigned w) { return __uint_as_float(w & 0xffff0000u); }
DI float wave_sum(float v) {
#pragma unroll
    for (int o = 32; o; o >>= 1) v += __shfl_xor(v, o);
    return v;
}
DI int crow(int i, int hh) { return (i & 3) + 8 * (i >> 2) + 4 * hh; }
DI float max3f(float a, float b, float c) { float r; asm("v_max3_f32 %0, %1, %2, %3" : "=v"(r) : "v"(a), "v"(b), "v"(c)); return r; }
DI float max2f(float a, float b) { float r; asm("v_max_f32_e32 %0, %1, %2" : "=v"(r) : "v"(a), "v"(b)); return r; }


#define XB_TMO      128
#define XB_XCNT(j)  (256  + 64 * (j))
#define XB_XSUB(j)  (1280 + 64 * (j))
#define XB_XGEN(j)  (2304 + 64 * (j))
#define XB_TOP      3328
#define XB_TOPGEN   3392
#define XCD_BAR_WORDS 3456
#define XB_SPIN_CAP (1u << 22)
DI unsigned xb_ld(unsigned* p)              { return __hip_atomic_load(p, __ATOMIC_RELAXED, __HIP_MEMORY_SCOPE_AGENT); }
DI unsigned xb_add(unsigned* p, unsigned v) { return __hip_atomic_fetch_add(p, v, __ATOMIC_RELAXED, __HIP_MEMORY_SCOPE_AGENT); }
DI unsigned xb_xcc_id() { return (unsigned)__builtin_amdgcn_s_getreg((3 << 11) | 20) & 0xFu; }
#define XB_SPIN(cond, bar) do { unsigned _sp = 0; while (cond) { __builtin_amdgcn_s_sleep(1); \
    if ((++_sp & 255u) == 0u) { if (xb_ld(&(bar)[XB_TMO])) break; if (_sp > XB_SPIN_CAP) { atomicAdd(&(bar)[XB_TMO], 1u); break; } } } } while (0)
struct XcdBarrier { unsigned* bar; unsigned x; volatile LDS_AS unsigned* st; };
DI XcdBarrier xcd_barrier_post(unsigned* bar, volatile LDS_AS unsigned* st) {
    XcdBarrier b; b.bar = bar; b.x = xb_xcc_id(); b.st = st;
    if (threadIdx.x == 0) (void)xb_add(&bar[XB_XCNT(b.x)], 1u);
    return b;
}
DI void xcd_barrier_complete(unsigned* bar, unsigned x, unsigned& nloc, unsigned& nx) {
    const unsigned G = gridDim.x * gridDim.y * gridDim.z;
    unsigned sum, cnt, mine, sp = 0u;
    for (;;) {
        sum = 0u; cnt = 0u; mine = 0u;
#pragma unroll
        for (unsigned j = 0; j < 16; ++j) { const unsigned c = xb_ld(&bar[XB_XCNT(j)]); sum += c; cnt += (c > 0u) ? 1u : 0u; mine = (j == x) ? c : mine; }
        if (sum == G) break;
        __builtin_amdgcn_s_sleep(1);
        if ((++sp & 255u) == 0u) { if (xb_ld(&bar[XB_TMO])) break; if (sp > XB_SPIN_CAP) { atomicAdd(&bar[XB_TMO], 1u); break; } }
    }
    nloc = mine > 0u ? mine : 1u; nx = cnt > 0u ? cnt : 1u;
}
DI void xcd_barrier(const XcdBarrier& b) {
    asm volatile("s_waitcnt vmcnt(0)" ::: "memory");
    __syncthreads();
    if (threadIdx.x == 0) {
        unsigned* bar = b.bar;
        __builtin_amdgcn_s_waitcnt(0);
        unsigned nloc = b.st[0], nx = b.st[1];
        if (nloc == 0u) { xcd_barrier_complete(bar, b.x, nloc, nx); b.st[0] = nloc; b.st[1] = nx; }
        const unsigned old = xb_add(&bar[XB_XSUB(b.x)], 1u);
        const unsigned gen = old / nloc;
        if (old + 1u == (gen + 1u) * nloc) {
            __builtin_amdgcn_fence(__ATOMIC_RELEASE, "agent");
            asm volatile("s_waitcnt vmcnt(0)" ::: "memory");
            const unsigned og = xb_add(&bar[XB_TOP], 1u);
            const unsigned tg = og / nx;
            if (og + 1u == (tg + 1u) * nx) xb_add(&bar[XB_TOPGEN], 1u);
            else XB_SPIN(xb_ld(&bar[XB_TOPGEN]) == tg, bar);
            __builtin_amdgcn_fence(__ATOMIC_ACQUIRE, "agent");
            xb_add(&bar[XB_XGEN(b.x)], 1u);
            asm volatile("s_waitcnt vmcnt(0)" ::: "memory");
        } else {
            XB_SPIN(xb_ld(&bar[XB_XGEN(b.x)]) == gen, bar);
            __builtin_amdgcn_fence(__ATOMIC_ACQUIRE, "agent");
            asm volatile("s_waitcnt vmcnt(0)" ::: "memory");
        }
    }
    __syncthreads();
}

DI void phase0(const Params& p, char* smem) {
    int tid_ = threadIdx.x; asm volatile("" : "+v"(tid_));
    const int tid = tid_, lane = tid & 63, wave = tid >> 6;
    float* tile = (float*)smem;
    for (int u = blockIdx.x; u < 1280; u += gridDim.x) {
        const float* src; int ld; bf16_t* dst;
        if (u < 1024) { const int kt = u >> 6, nt = u & 63; src = p.w_in + (size_t)(kt * 64) * INW + nt * 64; ld = INW; dst = p.wtin + (size_t)(nt * 64) * DM + kt * 64; }
        else { const int v = u - 1024, kt = v >> 4, nt = v & 15; src = p.w_out + (size_t)(kt * 64) * DM + nt * 64; ld = DM; dst = p.wtout + (size_t)(nt * 64) * DM + kt * 64; }
#pragma unroll
        for (int i = 0; i < 2; ++i) {
            const int r = (tid >> 4) + 32 * i, c = (tid & 15) * 4;
            const f32x4 v = *(const f32x4*)(src + (size_t)r * ld + c);
            tile[r * 65 + c] = v[0]; tile[r * 65 + c + 1] = v[1]; tile[r * 65 + c + 2] = v[2]; tile[r * 65 + c + 3] = v[3];
        }
        __syncthreads();
        {
            const int n = (tid >> 3), kc = (tid & 7) * 8;
            u32x4 w;
            w[0] = pk2(tile[(kc + 0) * 65 + n], tile[(kc + 1) * 65 + n]);
            w[1] = pk2(tile[(kc + 2) * 65 + n], tile[(kc + 3) * 65 + n]);
            w[2] = pk2(tile[(kc + 4) * 65 + n], tile[(kc + 5) * 65 + n]);
            w[3] = pk2(tile[(kc + 6) * 65 + n], tile[(kc + 7) * 65 + n]);
            *(u32x4*)(dst + (size_t)n * DM + kc) = w;
        }
        __syncthreads();
    }
    float* wf = (float*)smem;
#pragma unroll
    for (int i = 0; i < 2; ++i) {
        const int k = tid + 512 * i; const float* s = p.w_in + (size_t)k * INW + 4096;
        const f32x4 a = *(const f32x4*)s, b = *(const f32x4*)(s + 4);
        wf[0 * 1024 + k] = a[0]; wf[1 * 1024 + k] = a[1]; wf[2 * 1024 + k] = a[2]; wf[3 * 1024 + k] = a[3];
        wf[4 * 1024 + k] = b[0]; wf[5 * 1024 + k] = b[1]; wf[6 * 1024 + k] = b[2]; wf[7 * 1024 + k] = b[3];
    }
    __syncthreads();
    auto row_src = [&](int R) -> const float* {
        if (R < ROWS_P) {
            const int b = R / LPAD, t = R - b * LPAD;
            if (t >= LP) return nullptr;
            return t < NMETA ? p.meta + (size_t)t * DM : p.x_prompt + ((size_t)b * SEQ + t - NMETA) * DM;
        }
        return p.x_sample + (size_t)(R - ROWS_P) * DM;
    };
    LDS_AS const char* wfl = (LDS_AS const char*)smem;
    f32x4 gq[4];
#pragma unroll
    for (int i = 0; i < 4; ++i) gq[i] = *(const f32x4*)(p.norm_g + i * 256 + lane * 4);
    const float bfv = p.b_f[lane >> 3];
    f32x4 vn[4];
    {
        const int R0 = blockIdx.x * NW + wave;
        const float* s0 = R0 < NR ? row_src(R0) : nullptr; if (!s0) s0 = p.x_prompt;
#pragma unroll
        for (int i = 0; i < 4; ++i) vn[i] = *(const f32x4*)(s0 + i * 256 + lane * 4);
    }
    for (int R = blockIdx.x * NW + wave; R < NR; R += gridDim.x * NW) {
        const float* src = row_src(R); float* lf_out = nullptr;
        if (R < ROWS_P) { const int b = R / LPAD, t = R - b * LPAD; lf_out = p.out + O_PBL + ((size_t)b * LP + t) * 8; }
        else lf_out = p.out + O_SBL + (size_t)(R - ROWS_P) * 8;
        bf16_t* xr = p.xn + (size_t)R * DM;
        f32x4 v[4];
#pragma unroll
        for (int i = 0; i < 4; ++i) v[i] = vn[i];
        {
            const int Rn = R + gridDim.x * NW;
            const float* sn = Rn < NR ? row_src(Rn) : nullptr; if (!sn) sn = p.x_prompt;
#pragma unroll
            for (int i = 0; i < 4; ++i) vn[i] = *(const f32x4*)(sn + i * 256 + lane * 4);
        }
        if (!src) {
#pragma unroll
            for (int i = 0; i < 4; ++i) *(u32x2*)(xr + i * 256 + lane * 4) = (u32x2){0u, 0u};
            continue;
        }
        float ss = 0.f;
#pragma unroll
        for (int i = 0; i < 4; ++i) ss += v[i][0] * v[i][0] + v[i][1] * v[i][1] + v[i][2] * v[i][2] + v[i][3] * v[i][3];
        ss = wave_sum(ss);
        const float rstd = 1.0f / sqrtf(ss * (1.0f / 1024.0f) + EPS);
        float fa[8];
#pragma unroll
        for (int j = 0; j < 8; ++j) fa[j] = 0.f;
#pragma unroll
        for (int i = 0; i < 4; ++i) {
            const int k = i * 256 + lane * 4;
            const f32x4 xv = v[i] * rstd * gq[i];
            *(u32x2*)(xr + k) = (u32x2){pk2(xv[0], xv[1]), pk2(xv[2], xv[3])};
#pragma unroll
            for (int j = 0; j < 8; ++j) { const f32x4 w = *(LDS_AS const f32x4*)(wfl + (j * 1024 + k) * 4); fa[j] += xv[0] * w[0] + xv[1] * w[1] + xv[2] * w[2] + xv[3] * w[3]; }
        }
        const bool h5 = (lane & 32) != 0, h4 = (lane & 16) != 0, h3 = (lane & 8) != 0;
        float a4[4], a2[2];
#pragma unroll
        for (int j = 0; j < 4; ++j) { const float keep = h5 ? fa[4 + j] : fa[j], send = h5 ? fa[j] : fa[4 + j]; a4[j] = keep + __shfl_xor(send, 32); }
#pragma unroll
        for (int j = 0; j < 2; ++j) { const float keep = h4 ? a4[2 + j] : a4[j], send = h4 ? a4[j] : a4[2 + j]; a2[j] = keep + __shfl_xor(send, 16); }
        float c1;
        { const float keep = h3 ? a2[1] : a2[0], send = h3 ? a2[0] : a2[1]; c1 = keep + __shfl_xor(send, 8); }
        c1 += __shfl_xor(c1, 4); c1 += __shfl_xor(c1, 2); c1 += __shfl_xor(c1, 1);
        if ((lane & 7) == 0) {
            const float z = c1 + bfv;
            lf_out[lane >> 3] = fminf(z, 0.f) - log1pf(expf(-fabsf(z)));
        }
    }
    for (int i = blockIdx.x * NT + tid; i < NR; i += gridDim.x * NT) p.rowss[i] = 0.f;
    if (blockIdx.x == 0 && tid < 128) p.ctrl[tid] = 0u;
}

namespace pg8 {
#define PG8_LAS __attribute__((address_space(3)))
typedef unsigned short bf16_t;
typedef short bf16x8 __attribute__((ext_vector_type(8)));
typedef float f32x4 __attribute__((ext_vector_type(4)));
typedef unsigned u32x4 __attribute__((ext_vector_type(4)));
constexpr int BM = 256, BK = 64, HALF = 128, HTB = HALF * BK * 2  , STAGE_BYTES = 8 * HTB, NXCD = 8, WGM = 8;

__host__ __device__ __forceinline__ int lds_byte(int r, int c) { const int st = (r >> 4) * 2 + (c >> 5), rr = r & 15, cc = c & 31, ob = rr * 64 + cc * 2; return st * 1024 + (ob ^ (((ob >> 9) & 1) << 5)); }
__host__ __device__ __forceinline__ void stage_rc(int b, int& R, int& C) { const int st = b / 1024, sb = b % 1024, swz = sb ^ (((sb >> 9) & 1) << 5); R = (st >> 1) * 16 + swz / 64; C = (st & 1) * 32 + (swz % 64) / 2; }
__host__ __device__ __forceinline__ int perm32(int rho) { const int n = rho >> 4, i = rho & 15; return 8 * (i >> 2) + 4 * n + (i & 3); }

struct Unit { int pm, pn; };
struct Gemm { const bf16_t* A; const bf16_t* Bt; int M, N, K; };

struct StaticOrder {
    int nM, nN, nwg, G, c;
    __host__ __device__ void init(int M, int N, int G_, int c_) { nM = M / BM; nN = N / BM; nwg = nM * nN; G = G_; c = c_; }
    __host__ __device__ bool next(int i, Unit& u) const {
        const long L = (long)i * G + c; if (L >= nwg) return false;
        int wgid = (int)L; { const int q = nwg / NXCD, r = nwg % NXCD, xcd = wgid % NXCD, off = wgid / NXCD; wgid = (xcd < r ? xcd * (q + 1) : r * (q + 1) + (xcd - r) * q) + off; }
        const int nig = WGM * nN, gid = wgid / nig, fm = gid * WGM, gsz = (nM - fm) < WGM ? (nM - fm) : WGM;
        u.pm = fm + ((wgid % nig) % gsz); u.pn = (wgid % nig) / gsz; return true;
    }
    __device__ __forceinline__ void a_ready(const Unit&) const {}
    __device__ __forceinline__ void done(const Unit&) const {}
};

template <class Epi, class Sched, bool ALIGN_EPI = false, bool SP2 = false>
__device__ __forceinline__ void gemm_phase(PG8_LAS unsigned char* lds, const Gemm g, const Sched& S, const Epi& E) {
    const int tid = threadIdx.x, wid = __builtin_amdgcn_readfirstlane(tid >> 6), lane = tid & 63, wr = wid >> 2, wc = wid & 3, fr = lane & 15, fq = lane >> 4;
    const int K = g.K, nt = K / BK;
    unsigned voffA[2], voffB[2];
#pragma unroll
    for (int i = 0; i < 2; ++i) { int R, C; stage_rc(tid * 16 + i * 8192, R, C); const int Rb = Epi::PERM ? ((R & ~31) + perm32(R & 31)) : R;
        voffA[i] = (unsigned)(R * K + C) * 2u; voffB[i] = (unsigned)(Rb * K + C) * 2u; }
    const size_t kstep = (size_t)(BK * 2);
    const size_t hstep = (size_t)HALF * K * 2;
    const size_t tstep = 2 * hstep;
    const unsigned ldsw = (unsigned)wid * 1024u;
    const int aoff = lds_byte(wr * 64 + fr, fq * 8), boff = lds_byte(wc * 32 + fr, fq * 8);
#define PG8_SA(b, h) (((b) * 2 + (h)) * HTB)
#define PG8_SB(b, h) ((4 + (b) * 2 + (h)) * HTB)
#define PG8_STAGE(bufoff, gbase, voff) do { _Pragma("unroll") for (int _i = 0; _i < 2; ++_i) \
        __builtin_amdgcn_global_load_lds((const unsigned*)((const char*)(gbase) + (voff)[_i]), (PG8_LAS unsigned*)(lds + (bufoff) + ldsw + _i * 8192), 16, 0, 0); } while (0)
#define PG8_LDA(dst, b, h) do { _Pragma("unroll") for (int m = 0; m < 4; ++m) _Pragma("unroll") for (int k = 0; k < 2; ++k) dst[m][k] = *(const PG8_LAS bf16x8*)(lds + PG8_SA(b, h) + aoff + m * 2048 + k * 1024); } while (0)
#define PG8_LDB(dst, b, h) do { _Pragma("unroll") for (int n = 0; n < 2; ++n) _Pragma("unroll") for (int k = 0; k < 2; ++k) dst[n][k] = *(const PG8_LAS bf16x8*)(lds + PG8_SB(b, h) + boff + n * 2048 + k * 1024); } while (0)
#define PG8_MMA(ai, bj, At, Bt) do { __builtin_amdgcn_s_setprio(1); _Pragma("unroll") for (int m = 0; m < 4; ++m) _Pragma("unroll") for (int n = 0; n < 2; ++n) _Pragma("unroll") for (int k = 0; k < 2; ++k) \
        acc[ai][bj][m][n] = __builtin_amdgcn_mfma_f32_16x16x32_bf16(Bt[n][k], At[m][k], acc[ai][bj][m][n], 0, 0, 0); __builtin_amdgcn_s_setprio(0); } while (0)
#define PG8_WAIT_V(n) asm volatile("s_waitcnt vmcnt(" #n ")" ::: "memory")
#define PG8_WAIT_L(n) asm volatile("s_waitcnt lgkmcnt(" #n ")" ::: "memory")
#define PG8_BAR __builtin_amdgcn_s_barrier()
#define PG8_SCHED __builtin_amdgcn_sched_barrier(0)
    Unit cur, nxt; int ui = 0;
    if (!S.next(0, cur)) return;
    f32x4 acc[2][2][4][2];
#pragma unroll
    for (int a = 0; a < 2; ++a)
#pragma unroll
        for (int b = 0; b < 2; ++b)
#pragma unroll
            for (int m = 0; m < 4; ++m)
#pragma unroll
                for (int n = 0; n < 2; ++n) acc[a][b][m][n] = (f32x4){0.f, 0.f, 0.f, 0.f};
    bf16x8 At[4][2], B0[2][2], B1[2][2];
    const char* cA = (const char*)g.A + (size_t)cur.pm * tstep; const char* cB = (const char*)g.Bt + (size_t)cur.pn * tstep;
    S.a_ready(cur);
    if constexpr (SP2) {
        PG8_STAGE(PG8_SB(0, 0), cB, voffB); PG8_STAGE(PG8_SB(0, 1), cB + hstep, voffB); PG8_STAGE(PG8_SA(0, 0), cA, voffA); PG8_STAGE(PG8_SA(0, 1), cA + hstep, voffA);
        if (wr == 1) PG8_BAR;
        PG8_WAIT_V(2); PG8_BAR;
        PG8_STAGE(PG8_SB(1, 0), cB + kstep, voffB); PG8_STAGE(PG8_SA(1, 0), cA + kstep, voffA); PG8_STAGE(PG8_SB(1, 1), cB + hstep + kstep, voffB);
        PG8_WAIT_V(6); PG8_BAR;
    } else {
        PG8_STAGE(PG8_SB(0, 0), cB, voffB); PG8_STAGE(PG8_SA(0, 0), cA, voffA); PG8_STAGE(PG8_SB(0, 1), cB + hstep, voffB); PG8_STAGE(PG8_SA(0, 1), cA + hstep, voffA);
        if (wr == 1) PG8_BAR;
        PG8_WAIT_V(4); PG8_BAR;
        PG8_STAGE(PG8_SB(1, 0), cB + kstep, voffB); PG8_STAGE(PG8_SA(1, 0), cA + kstep, voffA); PG8_STAGE(PG8_SB(1, 1), cB + hstep + kstep, voffB);
        PG8_WAIT_V(6); PG8_BAR;
    }
    for (;;) {
        const bool has_next = S.next(ui + 1, nxt);
        const char* nA = has_next ? (const char*)g.A + (size_t)nxt.pm * tstep : cA; const char* nB = has_next ? (const char*)g.Bt + (size_t)nxt.pn * tstep : cB;
        for (int t = 0; t < nt; t += 2) {
            const bool last = (t == nt - 2);
            const char* a1 = cA + (size_t)(t + 1) * kstep;
            const char* a2 = last ? nA : cA + (size_t)(t + 2) * kstep; const char* b2 = last ? nB : cB + (size_t)(t + 2) * kstep;
            const char* a3 = a2 + kstep; const char* b3 = b2 + kstep;
            if (last && has_next) S.a_ready(nxt);
            if constexpr (SP2) {
            PG8_LDB(B0, 0, 0); PG8_LDB(B1, 0, 1); PG8_SCHED; PG8_LDA(At, 0, 0); PG8_STAGE(PG8_SA(1, 1), a1 + hstep, voffA);
            PG8_WAIT_V(8); PG8_WAIT_L(0); PG8_BAR; PG8_MMA(0, 0, At, B0); PG8_MMA(0, 1, At, B1); PG8_BAR; PG8_SCHED;
            PG8_LDA(At, 0, 1); PG8_STAGE(PG8_SB(0, 0), b2, voffB); PG8_STAGE(PG8_SB(0, 1), b2 + hstep, voffB); PG8_STAGE(PG8_SA(0, 0), a2, voffA);
            PG8_WAIT_V(8); PG8_WAIT_L(0); PG8_BAR; PG8_MMA(1, 0, At, B0); PG8_MMA(1, 1, At, B1); PG8_BAR; PG8_SCHED;
            PG8_LDB(B0, 1, 0); PG8_LDB(B1, 1, 1); PG8_SCHED; PG8_LDA(At, 1, 0); PG8_STAGE(PG8_SA(0, 1), a2 + hstep, voffA);
            PG8_WAIT_V(8); PG8_WAIT_L(0); PG8_BAR; PG8_MMA(0, 0, At, B0); PG8_MMA(0, 1, At, B1); PG8_BAR; PG8_SCHED;
            PG8_LDA(At, 1, 1); PG8_STAGE(PG8_SB(1, 0), b3, voffB); PG8_STAGE(PG8_SB(1, 1), b3 + hstep, voffB); PG8_STAGE(PG8_SA(1, 0), a3, voffA);
            PG8_WAIT_V(8); PG8_WAIT_L(0); PG8_BAR; PG8_MMA(1, 0, At, B0); PG8_MMA(1, 1, At, B1); PG8_BAR; PG8_SCHED;
            } else {
            PG8_LDB(B0, 0, 0); PG8_SCHED; PG8_LDA(At, 0, 0); PG8_STAGE(PG8_SA(1, 1), a1 + hstep, voffA);
            PG8_WAIT_L(8); PG8_BAR; PG8_WAIT_L(0); PG8_MMA(0, 0, At, B0); PG8_BAR; PG8_SCHED;
            PG8_LDB(B1, 0, 1); PG8_STAGE(PG8_SB(0, 0), b2, voffB);
            PG8_BAR; PG8_WAIT_L(0); PG8_MMA(0, 1, At, B1); PG8_BAR;
            PG8_LDA(At, 0, 1); PG8_STAGE(PG8_SA(0, 0), a2, voffA);
            PG8_BAR; PG8_WAIT_L(0); PG8_MMA(1, 0, At, B0); PG8_BAR; PG8_SCHED;
            PG8_STAGE(PG8_SB(0, 1), b2 + hstep, voffB);
            PG8_WAIT_V(6); PG8_BAR; PG8_MMA(1, 1, At, B1); PG8_BAR;
            PG8_LDB(B0, 1, 0); PG8_SCHED; PG8_LDA(At, 1, 0); PG8_STAGE(PG8_SA(0, 1), a2 + hstep, voffA);
            PG8_WAIT_L(8); PG8_BAR; PG8_WAIT_L(0); PG8_MMA(0, 0, At, B0); PG8_BAR; PG8_SCHED;
            PG8_LDB(B1, 1, 1); PG8_STAGE(PG8_SB(1, 0), b3, voffB);
            PG8_BAR; PG8_WAIT_L(0); PG8_MMA(0, 1, At, B1); PG8_BAR;
            PG8_LDA(At, 1, 1); PG8_STAGE(PG8_SA(1, 0), a3, voffA);
            PG8_BAR; PG8_WAIT_L(0); PG8_MMA(1, 0, At, B0); PG8_BAR; PG8_SCHED;
            PG8_STAGE(PG8_SB(1, 1), b3 + hstep, voffB);
            PG8_WAIT_V(6); PG8_BAR; PG8_MMA(1, 1, At, B1); PG8_BAR;
            }
        }
        if constexpr (ALIGN_EPI) { if (wr == 0) PG8_BAR; }
        if constexpr (!Epi::AFTER_DRAIN) { E(acc, cur, wr, wc, fr, fq); S.done(cur); }
        if (!has_next) break;
#pragma unroll
        for (int a = 0; a < 2; ++a)
#pragma unroll
            for (int b = 0; b < 2; ++b)
#pragma unroll
                for (int m = 0; m < 4; ++m)
#pragma unroll
                    for (int n = 0; n < 2; ++n) acc[a][b][m][n] = (f32x4){0.f, 0.f, 0.f, 0.f};
        cur = nxt; cA = nA; cB = nB; ++ui;
        if constexpr (ALIGN_EPI) { if (wr == 1) PG8_BAR; }
    }
    PG8_WAIT_V(0);
    if constexpr (!ALIGN_EPI) { if (wr == 0) PG8_BAR; }
    PG8_BAR;
    if constexpr (Epi::AFTER_DRAIN) { E.fused(acc, cur, wr, wc, fr, fq, lds, wid, lane); S.done(cur); }
#undef PG8_SA
#undef PG8_SB
#undef PG8_STAGE
#undef PG8_LDA
#undef PG8_LDB
#undef PG8_MMA
#undef PG8_WAIT_V
#undef PG8_WAIT_L
#undef PG8_BAR
#undef PG8_SCHED
}
}

struct EpiProj8 {
    static constexpr bool PERM = true, AFTER_DRAIN = false;
    const Params* pp;
    DI void operator()(const f32x4 (&acc)[2][2][4][2], const pg8::Unit& u, int wr, int wc, int fr, int fq) const {
        const Params& p = *pp;
        const int colt = u.pn * 256, seg = colt >> 9;
        const bool isq = (seg == 0) || (seg == 4), isg = (seg == 3) || (seg == 7), iskv = !isq && !isg;
        const int oi = seg == 1 ? 0 : seg == 2 ? 1 : seg == 5 ? 2 : 3;
#pragma unroll
        for (int ai = 0; ai < 2; ++ai)
#pragma unroll
            for (int m = 0; m < 4; ++m) {
                const int R = u.pm * 256 + ai * 128 + wr * 64 + m * 16 + fr;
                float* fo = nullptr;
                if (iskv) {
                    if (R < ROWS_P) { const int b = R / LPAD, t = R - b * LPAD; if (t < LP) fo = p.out + O_PAK + oi * PKV_SZ + ((size_t)b * LP + t) * 512 - seg * 512; }
                    else fo = p.out + O_SAK + oi * SKV_SZ + (size_t)(R - ROWS_P) * 512 - seg * 512;
                }
                bf16_t* uo = p.u + (size_t)R * NU;
#pragma unroll
                for (int bj = 0; bj < 2; ++bj) {
                    const int n = colt + bj * 128 + wc * 32 + 8 * fq;
                    f32x4 v0 = acc[ai][bj][m][0], v1 = acc[ai][bj][m][1];
                    if (fo) { *(f32x4*)(fo + n) = v0; *(f32x4*)(fo + n + 4) = v1; }
                    if (isq) { v0 = v0 * QSCALE; v1 = v1 * QSCALE; }
                    else if (isg) {
#pragma unroll
                        for (int j = 0; j < 4; ++j) { v0[j] = v0[j] / (1.0f + __expf(-v0[j])); v1[j] = v1[j] / (1.0f + __expf(-v1[j])); }
                    }
                    *(u32x4*)(uo + n) = (u32x4){pk2(v0[0], v0[1]), pk2(v0[2], v0[3]), pk2(v1[0], v1[1]), pk2(v1[2], v1[3])};
                }
            }
    }
};

struct EpiOut8 {
    static constexpr bool PERM = true, AFTER_DRAIN = false;
    const Params* pp;
    DI void operator()(const f32x4 (&acc)[2][2][4][2], const pg8::Unit& u, int wr, int wc, int fr, int fq) const {
        const Params& p = *pp;
        const int colt = u.pn * 256;
#pragma unroll
        for (int ai = 0; ai < 2; ++ai)
#pragma unroll
            for (int m = 0; m < 4; ++m) {
                const int R = u.pm * 256 + ai * 128 + wr * 64 + m * 16 + fr;
                const float* xs = nullptr; float* yd = nullptr;
                if (R < ROWS_P) { const int b = R / LPAD, t = R - b * LPAD; if (t >= NMETA && t < LP) { const size_t idx = ((size_t)b * SEQ + t - NMETA) * DM; xs = p.x_prompt + idx; yd = p.out + O_YP + idx; } }
                else { const size_t idx = (size_t)(R - ROWS_P) * DM; xs = p.x_sample + idx; yd = p.out + O_YS + idx; }
                float ss = 0.f;
                if (xs) {
#pragma unroll
                    for (int bj = 0; bj < 2; ++bj) {
                        const int n = colt + bj * 128 + wc * 32 + 8 * fq;
                        const f32x4 x0 = *(const f32x4*)(xs + n), x1 = *(const f32x4*)(xs + n + 4);
                        const f32x4 h0 = x0 + acc[ai][bj][m][0], h1 = x1 + acc[ai][bj][m][1];
                        *(f32x4*)(yd + n) = h0; *(f32x4*)(yd + n + 4) = h1;
                        ss += h0[0] * h0[0] + h0[1] * h0[1] + h0[2] * h0[2] + h0[3] * h0[3] + h1[0] * h1[0] + h1[1] * h1[1] + h1[2] * h1[2] + h1[3] * h1[3];
                    }
                }
                ss += __shfl_xor(ss, 16); ss += __shfl_xor(ss, 32);
                if (xs && fq == 0) atomicAdd(p.rowss + R, ss);
            }
    }
};

DI void scan_unit(const Params& p, int su) {
    const int lane = threadIdx.x & 63, wave = threadIdx.x >> 6;
    const int seq = su * NW + wave;
    const int e0 = lane * 65;
    float vals[65];
    if (seq < 32) {
        const int b = seq >> 3, h = seq & 7;
        const float* src = p.out + O_PBL + (size_t)b * LP * 8 + h;
        float* dst = p.c2p + (size_t)seq * LPAD;
#pragma unroll
        for (int i = 0; i < 65; ++i) { const int e = e0 + i; vals[i] = src[(size_t)(e < LP ? e : LP - 1) * 8]; }
        float s = 0.f;
#pragma unroll
        for (int i = 0; i < 65; ++i) s += (e0 + i < LP) ? vals[i] : 0.f;
        float incl = s;
#pragma unroll
        for (int o = 1; o < 64; o <<= 1) { const float t = __shfl_up(incl, o); if (lane >= o) incl += t; }
        float run = incl - s;
#pragma unroll
        for (int i = 0; i < 65; ++i) { const int e = e0 + i; if (e < LP) { run += vals[i]; dst[e] = run * LOG2E; } else dst[e] = 0.f; }
    } else {
        const int sq = seq - 32, bb = sq >> 3, h = sq & 7;
        const float* src0 = p.cbl + (size_t)bb * PAST * 8 + h;
        const float* src1 = p.out + O_SBL + (size_t)bb * DSQ * 8 + h;
        float* dst = p.c2s + (size_t)sq * LSK;
#pragma unroll
        for (int i = 0; i < 65; ++i) {
            const int e = e0 + i, ec = e < LSK ? e : LSK - 1;
            const float* pe = ec < PAST ? src0 + (size_t)ec * 8 : src1 + (size_t)(ec - PAST) * 8;
            vals[i] = *pe;
        }
        float s = 0.f;
#pragma unroll
        for (int i = 0; i < 65; ++i) s += (e0 + i < LSK) ? vals[i] : 0.f;
        float incl = s;
#pragma unroll
        for (int o = 1; o < 64; o <<= 1) { const float t = __shfl_up(incl, o); if (lane >= o) incl += t; }
        float run = incl - s;
#pragma unroll
        for (int i = 0; i < 65; ++i) { const int e = e0 + i; if (e < LSK) { run += vals[i]; dst[e] = run * LOG2E; } }
    }
}

struct AttnState { f32x16 o0, o1; float m, l; };

template <int MODE>
DI void attn_subtile(LDS_AS const char* Kl, LDS_AS const char* Vl, LDS_AS const char* biasl, const bf16x8 (&q)[4], AttnState& st, int kpos0, int qpos, bool need_mask, int lane) {
    const int l31 = lane & 31, hh = lane >> 5;
    f32x16 s;
    if (MODE == 1) {
#pragma unroll
        for (int g = 0; g < 4; ++g) { const f32x4 bv = *(LDS_AS const f32x4*)(biasl + (8 * g + 4 * hh) * 4); s[4 * g] = bv[0]; s[4 * g + 1] = bv[1]; s[4 * g + 2] = bv[2]; s[4 * g + 3] = bv[3]; }
    } else {
#pragma unroll
        for (int i = 0; i < 16; ++i) s[i] = 0.f;
    }
#pragma unroll
    for (int stp = 0; stp < 4; ++stp) { const bf16x8 kf = *(LDS_AS const bf16x8*)(Kl + l31 * 144 + (2 * stp + hh) * 16); s = MFMA(kf, q[stp], s); }
    if (MODE == 1) {
        if (need_mask) {
#pragma unroll
            for (int i = 0; i < 16; ++i) if (kpos0 + crow(i, hh) > qpos) s[i] = -INFINITY;
        }
        float mx = s[0];
#pragma unroll
        for (int i = 1; i < 16; ++i) mx = fmaxf(mx, s[i]);
        mx = fmaxf(mx, __shfl_xor(mx, 32));
        const float mn = fmaxf(st.m, mx);
        if (__any(mn > st.m)) { const float a = __builtin_amdgcn_exp2f(st.m - mn); st.o0 = st.o0 * a; st.o1 = st.o1 * a; st.l *= a; }
        st.m = mn;
        float ps = 0.f;
#pragma unroll
        for (int i = 0; i < 16; ++i) { s[i] = __builtin_amdgcn_exp2f(s[i] - mn); ps += s[i]; }
        st.l += ps;
    } else {
        f32x16 lk;
#pragma unroll
        for (int i = 0; i < 16; ++i) {
            const float z = s[i];
            const float e = __builtin_amdgcn_exp2f(-fabsf(z));
            const float sp = __builtin_amdgcn_logf(1.0f + e);
            float lkv = -fmaxf(z, 0.f) - sp;
            float lsv = z + lkv;
            if (need_mask && (kpos0 + crow(i, hh) >= qpos)) { lkv = 0.f; lsv = -INFINITY; }
            lk[i] = lkv; s[i] = lsv;
        }
        float tot[4], suf1[4], suf0[4];
#pragma unroll
        for (int g = 0; g < 4; ++g) { suf1[g] = lk[4 * g + 3] + lk[4 * g + 2]; suf0[g] = suf1[g] + lk[4 * g + 1]; tot[g] = suf0[g] + lk[4 * g]; }
        float pb[4], cs[4];
#pragma unroll
        for (int g = 0; g < 4; ++g) { pb[g] = __shfl_xor(tot[g], 32); cs[g] = tot[g] + pb[g]; }
        const float S3 = 0.f, S2 = cs[3], S1 = S2 + cs[2], S0 = S1 + cs[1], total = S0 + cs[0];
        const float Sg[4] = {S0, S1, S2, S3};
#pragma unroll
        for (int g = 0; g < 4; ++g) {
            const float base = st.l + Sg[g] + (hh == 0 ? pb[g] : 0.f);
            s[4 * g + 3] = __builtin_amdgcn_exp2f(s[4 * g + 3] + base);
            s[4 * g + 2] = __builtin_amdgcn_exp2f(s[4 * g + 2] + (base + lk[4 * g + 3]));
            s[4 * g + 1] = __builtin_amdgcn_exp2f(s[4 * g + 1] + (base + suf1[g]));
            s[4 * g + 0] = __builtin_amdgcn_exp2f(s[4 * g + 0] + (base + suf0[g]));
        }
        st.l += total;
    }
    bf16x8 pf[2];
#pragma unroll
    for (int s2 = 0; s2 < 2; ++s2) {
        u32x4 w;
        w[0] = pk2(s[8 * s2 + 0], s[8 * s2 + 1]); w[1] = pk2(s[8 * s2 + 2], s[8 * s2 + 3]);
        w[2] = pk2(s[8 * s2 + 4], s[8 * s2 + 5]); w[3] = pk2(s[8 * s2 + 6], s[8 * s2 + 7]);
        pf[s2] = __builtin_bit_cast(bf16x8, w);
    }
    const int i16 = lane & 15, qq = i16 >> 2, pp = i16 & 3, gg = (lane >> 4) & 1;
#pragma unroll
    for (int s2 = 0; s2 < 2; ++s2)
#pragma unroll
        for (int dt = 0; dt < 2; ++dt) {
            LDS_AS const char* a_lo = Vl + (16 * s2 + 4 * hh + qq) * 144 + (32 * dt + 16 * gg + 4 * pp) * 2;
            const s16x4 lo = __builtin_amdgcn_ds_read_tr16_b64_v4i16((LDS_AS s16x4*)a_lo);
            const s16x4 hi = __builtin_amdgcn_ds_read_tr16_b64_v4i16((LDS_AS s16x4*)(a_lo + 8 * 144));
            const bf16x8 vf = __builtin_shufflevector(lo, hi, 0, 1, 2, 3, 4, 5, 6, 7);
            if (dt == 0) st.o0 = MFMA(vf, pf[s2], st.o0); else st.o1 = MFMA(vf, pf[s2], st.o1);
        }
}

DI void fox_softmax32(f32x16& s, AttnState& st, bf16x8 (&pf)[2]) {
    float mx = max2f(s[0], s[1]);
#pragma unroll
    for (int i = 2; i < 16; i += 2) mx = max3f(mx, s[i], s[i + 1]);
    mx = max2f(mx, __shfl_xor(mx, 32));
    const float mn = max2f(st.m, mx);
    if (__any(mn > st.m)) { const float a = __builtin_amdgcn_exp2f(st.m - mn); st.o0 = st.o0 * a; st.o1 = st.o1 * a; st.l *= a; }
    st.m = mn;
    const f32x2 mn2 = {mn, mn};
    f32x2 acc2 = {0.f, 0.f};
#pragma unroll
    for (int i = 0; i < 16; i += 2) {
        f32x2 t = {s[i], s[i + 1]};
        t = t - mn2;
        t[0] = __builtin_amdgcn_exp2f(t[0]); t[1] = __builtin_amdgcn_exp2f(t[1]);
        acc2 = acc2 + t;
        s[i] = t[0]; s[i + 1] = t[1];
    }
    st.l += acc2[0] + acc2[1];
#pragma unroll
    for (int s2 = 0; s2 < 2; ++s2) {
        u32x4 w;
        w[0] = pk2(s[8 * s2 + 0], s[8 * s2 + 1]); w[1] = pk2(s[8 * s2 + 2], s[8 * s2 + 3]); w[2] = pk2(s[8 * s2 + 4], s[8 * s2 + 5]); w[3] = pk2(s[8 * s2 + 6], s[8 * s2 + 7]);
        pf[s2] = __builtin_bit_cast(bf16x8, w);
    }
}
DI void fox_pv32(LDS_AS const char* Vl, const bf16x8 (&pf)[2], AttnState& st, int lane) {
    const int hh = lane >> 5, i16 = lane & 15, qq = i16 >> 2, pp = i16 & 3, gg = (lane >> 4) & 1;
#pragma unroll
    for (int s2 = 0; s2 < 2; ++s2)
#pragma unroll
        for (int dt = 0; dt < 2; ++dt) {
            LDS_AS const char* a_lo = Vl + (16 * s2 + 4 * hh + qq) * 144 + (32 * dt + 16 * gg + 4 * pp) * 2;
            const s16x4 lo = __builtin_amdgcn_ds_read_tr16_b64_v4i16((LDS_AS s16x4*)a_lo);
            const s16x4 hi = __builtin_amdgcn_ds_read_tr16_b64_v4i16((LDS_AS s16x4*)(a_lo + 8 * 144));
            const bf16x8 vf = __builtin_shufflevector(lo, hi, 0, 1, 2, 3, 4, 5, 6, 7);
            if (dt == 0) st.o0 = MFMA(vf, pf[s2], st.o0); else st.o1 = MFMA(vf, pf[s2], st.o1);
        }
}
DI void attn_tile64_fox(LDS_AS const char* Kl, LDS_AS const char* Vl, LDS_AS const char* biasl, const bf16x8 (&q)[4], AttnState& st, int lane) {
    const int l31 = lane & 31, hh = lane >> 5;
    f32x16 s0, s1;
#pragma unroll
    for (int g = 0; g < 4; ++g) {
        const f32x4 b0 = *(LDS_AS const f32x4*)(biasl + (8 * g + 4 * hh) * 4);
        const f32x4 b1 = *(LDS_AS const f32x4*)(biasl + 128 + (8 * g + 4 * hh) * 4);
        s0[4 * g] = b0[0]; s0[4 * g + 1] = b0[1]; s0[4 * g + 2] = b0[2]; s0[4 * g + 3] = b0[3];
        s1[4 * g] = b1[0]; s1[4 * g + 1] = b1[1]; s1[4 * g + 2] = b1[2]; s1[4 * g + 3] = b1[3];
    }
    bf16x8 k0[4], k1[4];
#pragma unroll
    for (int stp = 0; stp < 4; ++stp) {
        k1[stp] = *(LDS_AS const bf16x8*)(Kl + 32 * 144 + l31 * 144 + (2 * stp + hh) * 16);
        k0[stp] = *(LDS_AS const bf16x8*)(Kl + l31 * 144 + (2 * stp + hh) * 16);
    }
#pragma unroll
    for (int stp = 0; stp < 4; ++stp) s1 = MFMA(k1[stp], q[stp], s1);
#pragma unroll
    for (int stp = 0; stp < 4; ++stp) s0 = MFMA(k0[stp], q[stp], s0);
    __builtin_amdgcn_sched_barrier(0);
    bf16x8 pf1[2], pf0[2];
    fox_softmax32(s1, st, pf1);
    __builtin_amdgcn_sched_barrier(0);
    fox_pv32(Vl + 32 * 144, pf1, st, lane);
    __builtin_amdgcn_sched_barrier(0);
    fox_softmax32(s0, st, pf0);
    __builtin_amdgcn_sched_barrier(0);
    fox_pv32(Vl, pf0, st, lane);
}

DI void store_gated(const AttnState& st, const bf16_t* sg, bf16_t* mo, int hh) {
#pragma unroll
    for (int dt = 0; dt < 2; ++dt)
#pragma unroll
        for (int g = 0; g < 4; ++g) {
            const int d = 32 * dt + 8 * g + 4 * hh;
            const u32x2 gv = *(const u32x2*)(sg + d);
            const f32x16& o = dt == 0 ? st.o0 : st.o1;
            const float a0 = o[4 * g] * bflo(gv[0]), a1 = o[4 * g + 1] * bfhi(gv[0]), a2 = o[4 * g + 2] * bflo(gv[1]), a3 = o[4 * g + 3] * bfhi(gv[1]);
            *(u32x2*)(mo + d) = (u32x2){pk2(a0, a1), pk2(a2, a3)};
        }
}

constexpr int PSTG = 18688;

template <int MODE>
DI void prompt_unit(const Params& p, int b, int h, int qt, char* smem) {
    int tid_ = threadIdx.x; asm volatile("" : "+v"(tid_));
    const int tid = tid_, lane = tid & 63, wave = tid >> 6, l31 = lane & 31, hh = lane >> 5;
    LDS_AS char* lb = (LDS_AS char*)smem;
    const int t0 = qt * 256, wq0 = t0 + 32 * wave;
    const int qpos = wq0 + l31;
    const bool wave_valid = wq0 < LP;
    const int qcol = (MODE == 0 ? 0 : 2048) + h * 64, kcol = qcol + 512, vcol = qcol + 1024, gcol = qcol + 1536;
    const size_t rowb = (size_t)b * LPAD;
    bf16x8 q[4];
    {
        const int qr = qpos < LPAD ? qpos : LPAD - 1;
        const bf16_t* qp = p.u + (rowb + qr) * NU + qcol + 8 * hh;
#pragma unroll
        for (int s = 0; s < 4; ++s) q[s] = *(const bf16x8*)(qp + 16 * s);
    }
    AttnState st;
#pragma unroll
    for (int i = 0; i < 16; ++i) { st.o0[i] = 0.f; st.o1[i] = 0.f; }
    st.m = -1e30f; st.l = 0.f;
    const int kt_max = (4 * qt + 3) < 64 ? (4 * qt + 3) : 64;
    const float* cb = p.c2p + (size_t)(b * 8 + h) * LPAD;
    float cref = 0.f;
    if (MODE == 1) cref = cb[t0 < LP ? t0 : LP - 1];
    u32x4 rk, rv; float rbias = 0.f;
    const int r0 = tid >> 3, c0 = tid & 7;
    auto pload = [&](int kt) {
        const bf16_t* kb = p.u + (rowb + (size_t)kt * 64 + r0) * NU + c0 * 8;
        rk = *(const u32x4*)(kb + kcol); rv = *(const u32x4*)(kb + vcol);
        if (MODE == 1 && tid < 64) rbias = cref - cb[kt * 64 + tid];
    };
    auto pstore = [&](int sg) {
        LDS_AS char* base = lb + sg * PSTG + r0 * 144 + c0 * 16;
        *(LDS_AS u32x4*)(base) = rk; *(LDS_AS u32x4*)(base + 9216) = rv;
        if (MODE == 1 && tid < 64) *(LDS_AS float*)(lb + sg * PSTG + 18432 + tid * 4) = rbias;
    };
    __syncthreads();
    pload(kt_max); pstore(0);
    __syncthreads();
    int stg = 0;
    bool wdone = !wave_valid;
    for (int kt = kt_max; kt >= 0; --kt) {
        if (kt > 0) pload(kt - 1);
        if (!wdone) {
            LDS_AS const char* sb = lb + stg * PSTG;
            if (MODE == 1 && kt * 64 + 63 < wq0) attn_tile64_fox(sb, sb + 9216, sb + 18432, q, st, lane);
            else
#pragma unroll
            for (int sub = 1; sub >= 0; --sub) {
                const int kp0 = kt * 64 + sub * 32;
                if (kp0 <= wq0 + 31) {
                    const bool nm = (kp0 + 31 >= wq0);
                    attn_subtile<MODE>(sb + sub * 32 * 144, sb + 9216 + sub * 32 * 144, sb + 18432 + sub * 128, q, st, kp0, qpos, nm, lane);
                }
            }
            if (MODE == 0) wdone = __all(st.l < -SB_THRESH);
        }
        if (kt > 0) pstore(stg ^ 1);
        if (MODE == 0) { if (__syncthreads_and(wdone ? 1 : 0)) break; }
        else __syncthreads();
        stg ^= 1;
    }
    if (MODE == 1) { const float lt = st.l + __shfl_xor(st.l, 32); const float inv = 1.0f / lt; st.o0 = st.o0 * inv; st.o1 = st.o1 * inv; }
    if (wave_valid && qpos < LP) store_gated(st, p.u + (rowb + qpos) * NU + gcol, p.mix + (rowb + qpos) * DM + (MODE == 0 ? 0 : 512) + h * 64, hh);
}

DI void prompt_sb_unit(const Params& p, int b, int h, int qt, char* smem) {
    int tid_ = threadIdx.x; asm volatile("" : "+v"(tid_));
    const int tid = tid_, lane = tid & 63, wave = tid >> 6, l31 = lane & 31, hh = lane >> 5;
    LDS_AS char* lb = (LDS_AS char*)smem + wave * 9216;
    const int wq0 = qt * 256 + 32 * wave, qpos = wq0 + l31;
    const int qcol = h * 64, kcol = qcol + 512, vcol = qcol + 1024, gcol = qcol + 1536;
    const size_t rowb = (size_t)b * LPAD;
    __syncthreads();
    if (wq0 < LP) {
        bf16x8 q[4];
        {
            const bf16_t* qp = p.u + (rowb + qpos) * NU + qcol + 8 * hh;
#pragma unroll
            for (int s = 0; s < 4; ++s) q[s] = *(const bf16x8*)(qp + 16 * s);
        }
        AttnState st;
#pragma unroll
        for (int i = 0; i < 16; ++i) { st.o0[i] = 0.f; st.o1[i] = 0.f; }
        st.m = -1e30f; st.l = 0.f;
        u32x4 rk[4], rv[4];
        const int r0 = lane >> 3, c0 = lane & 7;
        const bf16_t* ub = p.u + (rowb + r0) * NU + c0 * 8;
        int kp = wq0;
        {
            const bf16_t* kb = ub + (size_t)kp * NU;
#pragma unroll
            for (int i = 0; i < 4; ++i) { rk[i] = *(const u32x4*)(kb + (size_t)(8 * i) * NU + kcol); rv[i] = *(const u32x4*)(kb + (size_t)(8 * i) * NU + vcol); }
        }
        for (;;) {
            asm volatile("s_waitcnt lgkmcnt(0)" ::: "memory");
#pragma unroll
            for (int i = 0; i < 4; ++i) { *(LDS_AS u32x4*)(lb + (r0 + 8 * i) * 144 + c0 * 16) = rk[i]; *(LDS_AS u32x4*)(lb + 4608 + (r0 + 8 * i) * 144 + c0 * 16) = rv[i]; }
            const int kn = kp - 32;
            if (kn >= 0) {
                const bf16_t* kb = ub + (size_t)kn * NU;
#pragma unroll
                for (int i = 0; i < 4; ++i) { rk[i] = *(const u32x4*)(kb + (size_t)(8 * i) * NU + kcol); rv[i] = *(const u32x4*)(kb + (size_t)(8 * i) * NU + vcol); }
            }
            asm volatile("s_waitcnt lgkmcnt(0)" ::: "memory");
            attn_subtile<0>(lb, lb + 4608, lb, q, st, kp, qpos, kp == wq0, lane);
            if (kn < 0 || __all(st.l < -SB_THRESH)) break;
            kp = kn;
        }
        if (qpos < LP) store_gated(st, p.u + (rowb + qpos) * NU + gcol, p.mix + (rowb + qpos) * DM + h * 64, hh);
    }
}

template <int MODE>
DI void sample_unit(const Params& p, int bb, int split, char* smem, int cq = 0) {
    int tid_ = threadIdx.x; asm volatile("" : "+v"(tid_));
    const int tid = tid_, lane = tid & 63, wave = tid >> 6, l31 = lane & 31, hh = lane >> 5;
    LDS_AS char* lb = (LDS_AS char*)smem;
    const int h = wave;
    const int qpos = PAST + l31;
    const size_t Rq = (size_t)ROWS_P + bb * 32 + l31;
    const int segb = (MODE == 0 ? 0 : 2048);
    const int qcol = segb + h * 64, gcol = qcol + 1536;
    bf16x8 q[4];
    {
        const bf16_t* qp = p.u + Rq * NU + qcol + 8 * hh;
#pragma unroll
        for (int s = 0; s < 4; ++s) q[s] = *(const bf16x8*)(qp + 16 * s);
    }
    AttnState st;
#pragma unroll
    for (int i = 0; i < 16; ++i) { st.o0[i] = 0.f; st.o1[i] = 0.f; }
    st.m = -1e30f; st.l = 0.f;
    const float* ck = (MODE == 0 ? p.cak : p.cbk) + (size_t)bb * PAST * 512;
    const float* cv = (MODE == 0 ? p.cav : p.cbv) + (size_t)bb * PAST * 512;
    const int ntc = (MODE == 1 ? (PAST / NSPLIT / 32) : 128), kbase = (MODE == 1 ? (PAST / NSPLIT) * split : 0);
    const bool has_new = (MODE == 0) || (split == NSPLIT - 1);
    const float* cseq = p.c2s + (size_t)(bb * 8 + ((tid >> 5) & 7)) * LSK;
    float cref = 0.f;
    if (MODE == 1 && tid < 256) cref = cseq[PAST];
    constexpr int KOFF = 0, VOFF = 36864, BOFF = 73728, HSTR = 4608;
    bool wdone = false, alldone = false;
    if (has_new) {
        __syncthreads();
        const bf16_t* kb = p.u + ((size_t)ROWS_P + bb * 32) * NU + segb + 512;
#pragma unroll
        for (int i = 0; i < 4; ++i) {
            const int id = tid + 512 * i, r = id >> 6, c = id & 63, hd = c >> 3, d = (c & 7) * 8;
            const u32x4 kx = *(const u32x4*)(kb + (size_t)r * NU + c * 8);
            const u32x4 vx = *(const u32x4*)(kb + (size_t)r * NU + 512 + c * 8);
            *(LDS_AS u32x4*)(lb + KOFF + hd * HSTR + r * 144 + d * 2) = kx;
            *(LDS_AS u32x4*)(lb + VOFF + hd * HSTR + r * 144 + d * 2) = vx;
        }
        if (MODE == 1 && tid < 256) *(LDS_AS float*)(lb + BOFF + tid * 4) = cref - cseq[PAST + (tid & 31)];
        __syncthreads();
        attn_subtile<MODE>(lb + KOFF + wave * HSTR, lb + VOFF + wave * HSTR, lb + BOFF + wave * 128, q, st, PAST, qpos, true, lane);
        if (MODE == 0) { wdone = __all(st.l < -SB_THRESH); alldone = __syncthreads_and(wdone ? 1 : 0) != 0; }
    }
    if (!alldone) {
        f32x4 tk[8], tv[8]; float tb = 0.f;
        const int rot = (MODE == 1) ? ((bb * NSPLIT + split) * 5) % ntc : 0;
        {
            const int t0i = (ntc - 1 + rot) % ntc;
            const float* kg = ck + (size_t)(kbase + 32 * t0i) * 512;
            const float* vg = cv + (size_t)(kbase + 32 * t0i) * 512;
            if (MODE == 1 && tid < 256) tb = cseq[kbase + 32 * t0i + (tid & 31)];
#pragma unroll
            for (int i = 0; i < 8; ++i) { const int id = tid + 512 * i; tk[i] = __builtin_nontemporal_load((const f32x4*)(kg + (size_t)id * 4)); tv[i] = __builtin_nontemporal_load((const f32x4*)(vg + (size_t)id * 4)); }
        }
        for (int it = ntc - 1; it >= 0; --it) {
            const int kpos0 = kbase + 32 * ((it + rot) % ntc);
            const int kposn = kbase + 32 * ((it - 1 + rot + ntc) % ntc);
            __syncthreads();
#pragma unroll
            for (int i = 0; i < 8; ++i) {
                const int id = tid + 512 * i, r = id >> 7, c4 = id & 127, hd = c4 >> 4, d = (c4 & 15) * 4;
                *(LDS_AS u32x2*)(lb + KOFF + hd * HSTR + r * 144 + d * 2) = (u32x2){pk2(tk[i][0], tk[i][1]), pk2(tk[i][2], tk[i][3])};
                *(LDS_AS u32x2*)(lb + VOFF + hd * HSTR + r * 144 + d * 2) = (u32x2){pk2(tv[i][0], tv[i][1]), pk2(tv[i][2], tv[i][3])};
            }
            if (MODE == 1 && tid < 256) *(LDS_AS float*)(lb + BOFF + tid * 4) = cref - tb;
            if (it > 0) {
                const float* kg = ck + (size_t)kposn * 512;
                const float* vg = cv + (size_t)kposn * 512;
                if (MODE == 1 && tid < 256) tb = cseq[kposn + (tid & 31)];
#pragma unroll
                for (int i = 0; i < 8; ++i) { const int id = tid + 512 * i; tk[i] = __builtin_nontemporal_load((const f32x4*)(kg + (size_t)id * 4)); tv[i] = __builtin_nontemporal_load((const f32x4*)(vg + (size_t)id * 4)); }
            }
            __builtin_amdgcn_sched_barrier(0);
            __syncthreads();
            if (!wdone) {
                attn_subtile<MODE>(lb + KOFF + wave * HSTR, lb + VOFF + wave * HSTR, lb + BOFF + wave * 128, q, st, kpos0, qpos, false, lane);
                if (MODE == 0) wdone = __all(st.l < -SB_THRESH);
            }
            if (MODE == 0) { if (__syncthreads_and(wdone ? 1 : 0)) break; }
        }
    }
    if (MODE == 0) {
        store_gated(st, p.u + Rq * NU + gcol, p.mix + Rq * DM + h * 64, hh);
        return;
    }
    {
        const float lt = st.l + __shfl_xor(st.l, 32);
        float* pp = p.part + ((((size_t)bb * NSPLIT + split) * 8) + wave) * PART_STRIDE;
        if (hh == 0) { pp[l31] = st.m; pp[32 + l31] = lt; }
#pragma unroll
        for (int dt = 0; dt < 2; ++dt)
#pragma unroll
            for (int g = 0; g < 4; ++g) {
                const int d = 32 * dt + 8 * g + 4 * hh;
                const f32x16& o = dt == 0 ? st.o0 : st.o1;
                *(f32x4*)(pp + 64 + l31 * 64 + d) = (f32x4){o[4 * g], o[4 * g + 1], o[4 * g + 2], o[4 * g + 3]};
            }
    }
    asm volatile("s_waitcnt vmcnt(0)" ::: "memory");
    __syncthreads();
    LDS_AS int* sflag = (LDS_AS int*)((LDS_AS char*)smem + SM_UNIT_OFF + 4);
    if (tid == 0) {
        __builtin_amdgcn_fence(__ATOMIC_RELEASE, "agent");
        asm volatile("s_waitcnt vmcnt(0)" ::: "memory");
        const unsigned old = __hip_atomic_fetch_add(p.ctrl + cq + 8 + bb, 1u, __ATOMIC_RELAXED, __HIP_MEMORY_SCOPE_AGENT);
        const int lastf = (old == (unsigned)(NSPLIT - 1)) ? 1 : 0;
        if (lastf) { __builtin_amdgcn_fence(__ATOMIC_ACQUIRE, "agent"); asm volatile("s_waitcnt vmcnt(0)" ::: "memory"); }
        *sflag = lastf;
    }
    __syncthreads();
    const int last = *sflag;
    if (!last) return;
    {
        const int hd = tid >> 6, qi = (tid & 63) >> 1, d0 = (tid & 1) * 32;
        const float* pb = p.part + (((size_t)bb * NSPLIT) * 8 + hd) * PART_STRIDE;
        float M = -1e30f;
#pragma unroll 1
        for (int s = 0; s < NSPLIT; ++s) M = fmaxf(M, __builtin_nontemporal_load(pb + (size_t)s * 8 * PART_STRIDE + qi));
        float L = 0.f; float o[32];
#pragma unroll
        for (int j = 0; j < 32; ++j) o[j] = 0.f;
#pragma unroll 1
        for (int s = 0; s < NSPLIT; ++s) {
            const float* ps = pb + (size_t)s * 8 * PART_STRIDE;
            const float w = __builtin_amdgcn_exp2f(__builtin_nontemporal_load(ps + qi) - M);
            L += w * __builtin_nontemporal_load(ps + 32 + qi);
#pragma unroll
            for (int j = 0; j < 8; ++j) { const f32x4 v = *(const f32x4*)(ps + 64 + qi * 64 + d0 + 4 * j); o[4 * j] += w * v[0]; o[4 * j + 1] += w * v[1]; o[4 * j + 2] += w * v[2]; o[4 * j + 3] += w * v[3]; }
        }
        const float inv = 1.0f / L;
        const size_t R = (size_t)ROWS_P + bb * 32 + qi;
        const int hcol = hd * 64 + d0;
        const bf16_t* sg = p.u + R * NU + 3584 + hcol;
        bf16_t* mo = p.mix + R * DM + 512 + hcol;
#pragma unroll
        for (int j = 0; j < 8; ++j) {
            const u32x2 gv = *(const u32x2*)(sg + 4 * j);
            *(u32x2*)(mo + 4 * j) = (u32x2){pk2(o[4 * j] * inv * bflo(gv[0]), o[4 * j + 1] * inv * bfhi(gv[0])), pk2(o[4 * j + 2] * inv * bflo(gv[1]), o[4 * j + 3] * inv * bfhi(gv[1]))};
        }
    }
}

constexpr int NU_SF = DB * NSPLIT, NU_PF = 32 * 17, NU_SS = DB, NU_PS = 32 * 17;

__global__ void __launch_bounds__(512, 2) hymba_mega(Params p) {
    extern __shared__ __attribute__((aligned(16))) char smem[];
    const int tid = threadIdx.x;
    volatile LDS_AS unsigned* xbst = (volatile LDS_AS unsigned*)((LDS_AS char*)smem + 131072);
    if (tid == 0) { xbst[0] = 0u; xbst[1] = 0u; xbst[2] = 0u; xbst[3] = 0u; }
    __syncthreads();
    const XcdBarrier xb = xcd_barrier_post(p.bar, xbst);

    phase0(p, smem);
    xcd_barrier(xb);

    {
        const int su = (int)gridDim.x - 1 - (int)blockIdx.x;
        if (su < 20) scan_unit(p, su);
        __syncthreads();
        pg8::StaticOrder S; S.init(NR, 4096, (int)gridDim.x, (int)blockIdx.x);
        const pg8::Gemm g{p.xn, p.wtin, NR, 4096, DM};
        const EpiProj8 E{&p};
        pg8::gemm_phase<EpiProj8, pg8::StaticOrder, true, true>((PG8_LAS unsigned char*)smem, g, S, E);
        xcd_barrier(xb);
#if DUP_P1
        pg8::gemm_phase<EpiProj8, pg8::StaticOrder, true, true>((PG8_LAS unsigned char*)smem, g, S, E);
        xcd_barrier(xb);
#endif
    }

    for (int rep = 0; rep < 1 + DUP_P2; ++rep) {
        const int cq = rep * 64;
        LDS_AS int* sunit = (LDS_AS int*)((LDS_AS char*)smem + SM_UNIT_OFF);
#define QUEUE_LOOP(QI, NUNITS, BODY) \
        for (;;) { \
            __syncthreads(); \
            if (tid == 0) *sunit = (int)atomicAdd(p.ctrl + cq + (QI), 1u); \
            __syncthreads(); \
            const int u = *sunit; \
            if (u >= (NUNITS)) break; \
            BODY; \
        }
        const bool streamer = ((blockIdx.x >> 3) & 3) == 0;
        for (int ph = 0; ph < 4; ++ph) {
            const int qi = streamer ? (ph == 0 ? 0 : ph == 1 ? 2 : ph == 2 ? 1 : 3) : (ph == 0 ? 1 : ph == 1 ? 0 : ph == 2 ? 2 : 3);
            if (qi == 0) { QUEUE_LOOP(0, NU_SF, sample_unit<1>(p, u / NSPLIT, u % NSPLIT, smem, cq)) }
            else if (qi == 1) { QUEUE_LOOP(1, NU_PF, prompt_unit<1>(p, (u & 31) >> 3, u & 7, 16 - (u >> 5), smem)) }
            else if (qi == 2) { QUEUE_LOOP(2, NU_SS, sample_unit<0>(p, u, 0, smem)) }
            else { QUEUE_LOOP(3, NU_PS, prompt_sb_unit(p, (u & 31) >> 3, u & 7, 16 - (u >> 5), smem)) }
        }
        xcd_barrier(xb);
    }

    {
        pg8::StaticOrder S; S.init(NR, DM, (int)gridDim.x, (int)blockIdx.x);
        const pg8::Gemm g{p.mix, p.wtout, NR, DM, DM};
        const EpiOut8 E{&p};
        pg8::gemm_phase<EpiOut8, pg8::StaticOrder, true, true>((PG8_LAS unsigned char*)smem, g, S, E);
    }
    xcd_barrier(xb);

    {
        const int lane = tid & 63, wave = tid >> 6;
        auto row_dst = [&](int R) -> float* {
            if (R < ROWS_P) { const int b = R / LPAD, t = R - b * LPAD; if (t >= NMETA && t < LP) return p.out + O_YP + ((size_t)b * SEQ + t - NMETA) * DM; return nullptr; }
            return p.out + O_YS + (size_t)(R - ROWS_P) * DM;
        };
        f32x4 gq[4];
#pragma unroll
        for (int i = 0; i < 4; ++i) gq[i] = *(const f32x4*)(p.final_g + i * 256 + lane * 4);
        f32x4 vn[4]; float rn;
        {
            const int R0 = blockIdx.x * NW + wave;
            float* d0 = R0 < NR ? row_dst(R0) : nullptr; if (!d0) d0 = p.out + O_YS;
            rn = p.rowss[R0 < NR ? R0 : 0];
#pragma unroll
            for (int i = 0; i < 4; ++i) vn[i] = *(const f32x4*)(d0 + i * 256 + lane * 4);
        }
        for (int R = blockIdx.x * NW + wave; R < NR; R += gridDim.x * NW) {
            float* yd = row_dst(R);
            f32x4 v[4]; const float rs = rn;
#pragma unroll
            for (int i = 0; i < 4; ++i) v[i] = vn[i];
            {
                const int Rn = R + gridDim.x * NW;
                float* dn = Rn < NR ? row_dst(Rn) : nullptr; if (!dn) dn = p.out + O_YS;
                rn = p.rowss[Rn < NR ? Rn : 0];
#pragma unroll
                for (int i = 0; i < 4; ++i) vn[i] = *(const f32x4*)(dn + i * 256 + lane * 4);
            }
            if (!yd) continue;
            const float rstd = 1.0f / sqrtf(rs * (1.0f / 1024.0f) + EPS);
#pragma unroll
            for (int i = 0; i < 4; ++i) *(f32x4*)(yd + i * 256 + lane * 4) = v[i] * rstd * gq[i];
        }
    }
}

static inline size_t align_up(size_t x) { return (x + 255) & ~(size_t)255; }

extern "C" void kernel_launch(void* const* d_in, const int* in_sizes, int n_in, void* d_out, int out_size, void* d_ws, size_t ws_size, hipStream_t stream) {
    Params p{};
    p.x_prompt = (const float*)d_in[0]; p.x_sample = (const float*)d_in[1];
    p.cak = (const float*)d_in[2]; p.cav = (const float*)d_in[3]; p.cbk = (const float*)d_in[4]; p.cbv = (const float*)d_in[5]; p.cbl = (const float*)d_in[6];
    p.meta = (const float*)d_in[7]; p.norm_g = (const float*)d_in[8]; p.w_in = (const float*)d_in[9]; p.b_f = (const float*)d_in[10];
    p.w_out = (const float*)d_in[11]; p.final_g = (const float*)d_in[12];
    p.out = (float*)d_out;
    char* w = (char*)d_ws; size_t off = 0;
    p.ctrl = (unsigned*)(w + off); off = align_up(off + 4096);
    p.bar = (unsigned*)(w + off); off = align_up(off + XCD_BAR_WORDS * 4);
    p.rowss = (float*)(w + off); off = align_up(off + (size_t)NR * 4);
    p.wtin = (bf16_t*)(w + off); off = align_up(off + (size_t)4096 * DM * 2);
    p.wtout = (bf16_t*)(w + off); off = align_up(off + (size_t)DM * DM * 2);
    p.xn = (bf16_t*)(w + off); off = align_up(off + (size_t)NR * DM * 2);
    p.u = (bf16_t*)(w + off); off = align_up(off + (size_t)NR * NU * 2);
    p.mix = (bf16_t*)(w + off); off = align_up(off + (size_t)NR * DM * 2);
    p.c2p = (float*)(w + off); off = align_up(off + (size_t)32 * LPAD * 4);
    p.c2s = (float*)(w + off); off = align_up(off + (size_t)128 * LSK * 4);
    p.part = (float*)(w + off); off = align_up(off + (size_t)DB * NSPLIT * 8 * PART_STRIDE * 4);
    static int grid_blocks = 0;
    if (!grid_blocks) {
        int dev = 0, cus = 0, per_cu = 0;
        hipGetDevice(&dev);
        hipFuncSetAttribute((const void*)hymba_mega, hipFuncAttributeMaxDynamicSharedMemorySize, SMEM_BYTES);
        hipDeviceGetAttribute(&cus, hipDeviceAttributeMultiprocessorCount, dev);
        hipOccupancyMaxActiveBlocksPerMultiprocessor(&per_cu, hymba_mega, NT, SMEM_BYTES);
        if (per_cu > 1) per_cu = 1;
        grid_blocks = cus * per_cu;
        if (grid_blocks <= 0) grid_blocks = 256;
    }
    hipMemsetAsync(p.bar, 0, XCD_BAR_WORDS * 4, stream);
    void* args[] = {&p};
    hipError_t e = hipLaunchCooperativeKernel((void*)hymba_mega, dim3(grid_blocks), dim3(NT), args, SMEM_BYTES, stream);
    if (e != hipSuccess) fprintf(stderr, "cooperative launch failed: %s (grid %d)\n", hipGetErrorString(e), grid_blocks);
}
```

```cpp
#include <hip/hip_runtime.h>
#include <hip/hip_cooperative_groups.h>
#include <cstdio>
#include <cstdint>
namespace cg = cooperative_groups;

typedef unsigned short bf16_t;
typedef short bf16x8 __attribute__((ext_vector_type(8)));
typedef short s16x4 __attribute__((ext_vector_type(4)));
typedef float f32x16 __attribute__((ext_vector_type(16)));
typedef float f32x4 __attribute__((ext_vector_type(4)));
typedef float f32x2 __attribute__((ext_vector_type(2)));
typedef unsigned u32x4 __attribute__((ext_vector_type(4)));
typedef unsigned u32x2 __attribute__((ext_vector_type(2)));
typedef __bf16 bf16x2v __attribute__((ext_vector_type(2)));

#define DI __device__ __forceinline__
#define LDS_AS __attribute__((address_space(3)))
#define MFMA(a, b, c) __builtin_amdgcn_mfma_f32_32x32x16_bf16((a), (b), (c), 0, 0, 0)

constexpr int DM = 1024;
constexpr int NB = 4, SEQ = 4096, NMETA = 16, LP = 4112, LPAD = 4160;
constexpr int DB = 16, DSQ = 32, PAST = 4096, LSK = 4128;
constexpr int ROWS_P = NB * LPAD;
constexpr int ROWS_S = DB * DSQ;
constexpr int NR = ROWS_P + ROWS_S;
constexpr int INW = 4104;
constexpr int NU = 4096;
constexpr float EPS = 1e-6f;
constexpr float LOG2E = 1.4426950408889634f;
constexpr float QSCALE = 0.125f * LOG2E;
constexpr float SB_THRESH = 48.0f;

constexpr size_t O_YP = 0;
constexpr size_t O_YS = O_YP + (size_t)NB * SEQ * DM;
constexpr size_t PKV_SZ = (size_t)NB * LP * 512;
constexpr size_t SKV_SZ = (size_t)DB * DSQ * 512;
constexpr size_t O_PAK = O_YS + (size_t)DB * DSQ * DM;
constexpr size_t O_PBL = O_PAK + 4 * PKV_SZ;
constexpr size_t O_SAK = O_PBL + (size_t)NB * LP * 8;
constexpr size_t O_SBL = O_SAK + 4 * SKV_SZ;

#ifndef DUP_P1
#define DUP_P1 0
#endif
#ifndef DUP_P2
#define DUP_P2 0
#endif
constexpr int NT = 512, NW = 8;
constexpr int SMEM_BYTES = 131072 + 256;
constexpr int SM_UNIT_OFF = 131072 + 64;
constexpr int PART_STRIDE = 64 + 32 * 64;
constexpr int NSPLIT = 4;

struct Params {
    const float *x_prompt, *x_sample, *cak, *cav, *cbk, *cbv, *cbl, *meta, *norm_g, *w_in, *b_f, *w_out, *final_g;
    float* out;
    unsigned* ctrl; unsigned* bar; float* rowss; bf16_t *wtin, *wtout, *xn, *u, *mix; float *c2p, *c2s, *part;
};

DI unsigned pk2(float a, float b) { f32x2 v = {a, b}; bf16x2v r = __builtin_convertvector(v, bf16x2v); return __builtin_bit_cast(unsigned, r); }
DI float bflo(unsigned w) { return __uint_as_float(w << 16); }
DI float bfhi(unsigned w) { return __uint_as_float(w & 0xffff0000u); }
DI float wave_sum(float v) {
#pragma unroll
    for (int o = 32; o; o >>= 1) v += __shfl_xor(v, o);
    return v;
}
DI int crow(int i, int hh) { return (i & 3) + 8 * (i >> 2) + 4 * hh; }
DI float max3f(float a, float b, float c) { float r; asm("v_max3_f32 %0, %1, %2, %3" : "=v"(r) : "v"(a), "v"(b), "v"(c)); return r; }
DI float max2f(float a, float b) { float r; asm("v_max_f32_e32 %0, %1, %2" : "=v"(r) : "v"(a), "v"(b)); return r; }


#define XB_TMO      128
#define XB_XCNT(j)  (256  + 64 * (j))
#define XB_XSUB(j)  (1280 + 64 * (j))
#define XB_XGEN(j)  (2304 + 64 * (j))
#define XB_TOP      3328
#define XB_TOPGEN   3392
#define XCD_BAR_WORDS 3456
#define XB_SPIN_CAP (1u << 22)
DI unsigned xb_ld(unsigned* p)              { return __hip_atomic_load(p, __ATOMIC_RELAXED, __HIP_MEMORY_SCOPE_AGENT); }
DI unsigned xb_add(unsigned* p, unsigned v) { return __hip_atomic_fetch_add(p, v, __ATOMIC_RELAXED, __HIP_MEMORY_SCOPE_AGENT); }
DI unsigned xb_xcc_id() { return (unsigned)__builtin_amdgcn_s_getreg((3 << 11) | 20) & 0xFu; }
#define XB_SPIN(cond, bar) do { unsigned _sp = 0; while (cond) { __builtin_amdgcn_s_sleep(1); \
    if ((++_sp & 255u) == 0u) { if (xb_ld(&(bar)[XB_TMO])) break; if (_sp > XB_SPIN_CAP) { atomicAdd(&(bar)[XB_TMO], 1u); break; } } } } while (0)
struct XcdBarrier { unsigned* bar; unsigned x; volatile LDS_AS unsigned* st; };
DI XcdBarrier xcd_barrier_post(unsigned* bar, volatile LDS_AS unsigned* st) {
    XcdBarrier b; b.bar = bar; b.x = xb_xcc_id(); b.st = st;
    if (threadIdx.x == 0) (void)xb_add(&bar[XB_XCNT(b.x)], 1u);
    return b;
}
DI void xcd_barrier_complete(unsigned* bar, unsigned x, unsigned& nloc, unsigned& nx) {
    const unsigned G = gridDim.x * gridDim.y * gridDim.z;
    unsigned sum, cnt, mine, sp = 0u;
    for (;;) {
        sum = 0u; cnt = 0u; mine = 0u;
#pragma unroll
        for (unsigned j = 0; j < 16; ++j) { const unsigned c = xb_ld(&bar[XB_XCNT(j)]); sum += c; cnt += (c > 0u) ? 1u : 0u; mine = (j == x) ? c : mine; }
        if (sum == G) break;
        __builtin_amdgcn_s_sleep(1);
        if ((++sp & 255u) == 0u) { if (xb_ld(&bar[XB_TMO])) break; if (sp > XB_SPIN_CAP) { atomicAdd(&bar[XB_TMO], 1u); break; } }
    }
    nloc = mine > 0u ? mine : 1u; nx = cnt > 0u ? cnt : 1u;
}
DI void xcd_barrier(const XcdBarrier& b) {
    asm volatile("s_waitcnt vmcnt(0)" ::: "memory");
    __syncthreads();
    if (threadIdx.x == 0) {
        unsigned* bar = b.bar;
        __builtin_amdgcn_s_waitcnt(0);
        unsigned nloc = b.st[0], nx = b.st[1];
        if (nloc == 0u) { xcd_barrier_complete(bar, b.x, nloc, nx); b.st[0] = nloc; b.st[1] = nx; }
        const unsigned old = xb_add(&bar[XB_XSUB(b.x)], 1u);
        const unsigned gen = old / nloc;
        if (old + 1u == (gen + 1u) * nloc) {
            __builtin_amdgcn_fence(__ATOMIC_RELEASE, "agent");
            asm volatile("s_waitcnt vmcnt(0)" ::: "memory");
            const unsigned og = xb_add(&bar[XB_TOP], 1u);
            const unsigned tg = og / nx;
            if (og + 1u == (tg + 1u) * nx) xb_add(&bar[XB_TOPGEN], 1u);
            else XB_SPIN(xb_ld(&bar[XB_TOPGEN]) == tg, bar);
            __builtin_amdgcn_fence(__ATOMIC_ACQUIRE, "agent");
            xb_add(&bar[XB_XGEN(b.x)], 1u);
            asm volatile("s_waitcnt vmcnt(0)" ::: "memory");
        } else {
            XB_SPIN(xb_ld(&bar[XB_XGEN(b.x)]) == gen, bar);
            __builtin_amdgcn_fence(__ATOMIC_ACQUIRE, "agent");
            asm volatile("s_waitcnt vmcnt(0)" ::: "memory");
        }
    }
    __syncthreads();
}

DI void phase0(const Params& p, char* smem) {
    int tid_ = threadIdx.x; asm volatile("" : "+v"(tid_));
    const int tid = tid_, lane = tid & 63, wave = tid >> 6;
    float* tile = (float*)smem;
    for (int u = blockIdx.x; u < 1280; u += gridDim.x) {
        const float* src; int ld; bf16_t* dst;
        if (u < 1024) { const int kt = u >> 6, nt = u & 63; src = p.w_in + (size_t)(kt * 64) * INW + nt * 64; ld = INW; dst = p.wtin + (size_t)(nt * 64) * DM + kt * 64; }
        else { const int v = u - 1024, kt = v >> 4, nt = v & 15; src = p.w_out + (size_t)(kt * 64) * DM + nt * 64; ld = DM; dst = p.wtout + (size_t)(nt * 64) * DM + kt * 64; }
#pragma unroll
        for (int i = 0; i < 2; ++i) {
            const int r = (tid >> 4) + 32 * i, c = (tid & 15) * 4;
            const f32x4 v = *(const f32x4*)(src + (size_t)r * ld + c);
            tile[r * 65 + c] = v[0]; tile[r * 65 + c + 1] = v[1]; tile[r * 65 + c + 2] = v[2]; tile[r * 65 + c + 3] = v[3];
        }
        __syncthreads();
        {
            const int n = (tid >> 3), kc = (tid & 7) * 8;
            u32x4 w;
            w[0] = pk2(tile[(kc + 0) * 65 + n], tile[(kc + 1) * 65 + n]);
            w[1] = pk2(tile[(kc + 2) * 65 + n], tile[(kc + 3) * 65 + n]);
            w[2] = pk2(tile[(kc + 4) * 65 + n], tile[(kc + 5) * 65 + n]);
            w[3] = pk2(tile[(kc + 6) * 65 + n], tile[(kc + 7) * 65 + n]);
            *(u32x4*)(dst + (size_t)n * DM + kc) = w;
        }
        __syncthreads();
    }
    float* wf = (float*)smem;
#pragma unroll
    for (int i = 0; i < 2; ++i) {
        const int k = tid + 512 * i; const float* s = p.w_in + (size_t)k * INW + 4096;
        const f32x4 a = *(const f32x4*)s, b = *(const f32x4*)(s + 4);
        wf[0 * 1024 + k] = a[0]; wf[1 * 1024 + k] = a[1]; wf[2 * 1024 + k] = a[2]; wf[3 * 1024 + k] = a[3];
        wf[4 * 1024 + k] = b[0]; wf[5 * 1024 + k] = b[1]; wf[6 * 1024 + k] = b[2]; wf[7 * 1024 + k] = b[3];
    }
    __syncthreads();
    auto row_src = [&](int R) -> const float* {
        if (R < ROWS_P) {
            const int b = R / LPAD, t = R - b * LPAD;
            if (t >= LP) return nullptr;
            return t < NMETA ? p.meta + (size_t)t * DM : p.x_prompt + ((size_t)b * SEQ + t - NMETA) * DM;
        }
        return p.x_sample + (size_t)(R - ROWS_P) * DM;
    };
    LDS_AS const char* wfl = (LDS_AS const char*)smem;
    f32x4 gq[4];
#pragma unroll
    for (int i = 0; i < 4; ++i) gq[i] = *(const f32x4*)(p.norm_g + i * 256 + lane * 4);
    const float bfv = p.b_f[lane >> 3];
    f32x4 vn[4];
    {
        const int R0 = blockIdx.x * NW + wave;
        const float* s0 = R0 < NR ? row_src(R0) : nullptr; if (!s0) s0 = p.x_prompt;
#pragma unroll
        for (int i = 0; i < 4; ++i) vn[i] = *(const f32x4*)(s0 + i * 256 + lane * 4);
    }
    for (int R = blockIdx.x * NW + wave; R < NR; R += gridDim.x * NW) {
        const float* src = row_src(R); float* lf_out = nullptr;
        if (R < ROWS_P) { const int b = R / LPAD, t = R - b * LPAD; lf_out = p.out + O_PBL + ((size_t)b * LP + t) * 8; }
        else lf_out = p.out + O_SBL + (size_t)(R - ROWS_P) * 8;
        bf16_t* xr = p.xn + (size_t)R * DM;
        f32x4 v[4];
#pragma unroll
        for (int i = 0; i < 4; ++i) v[i] = vn[i];
        {
            const int Rn = R + gridDim.x * NW;
            const float* sn = Rn < NR ? row_src(Rn) : nullptr; if (!sn) sn = p.x_prompt;
#pragma unroll
            for (int i = 0; i < 4; ++i) vn[i] = *(const f32x4*)(sn + i * 256 + lane * 4);
        }
        if (!src) {
#pragma unroll
            for (int i = 0; i < 4; ++i) *(u32x2*)(xr + i * 256 + lane * 4) = (u32x2){0u, 0u};
            continue;
        }
        float ss = 0.f;
#pragma unroll
        for (int i = 0; i < 4; ++i) ss += v[i][0] * v[i][0] + v[i][1] * v[i][1] + v[i][2] * v[i][2] + v[i][3] * v[i][3];
        ss = wave_sum(ss);
        const float rstd = 1.0f / sqrtf(ss * (1.0f / 1024.0f) + EPS);
        float fa[8];
#pragma unroll
        for (int j = 0; j < 8; ++j) fa[j] = 0.f;
#pragma unroll
        for (int i = 0; i < 4; ++i) {
            const int k = i * 256 + lane * 4;
            const f32x4 xv = v[i] * rstd * gq[i];
            *(u32x2*)(xr + k) = (u32x2){pk2(xv[0], xv[1]), pk2(xv[2], xv[3])};
#pragma unroll
            for (int j = 0; j < 8; ++j) { const f32x4 w = *(LDS_AS const f32x4*)(wfl + (j * 1024 + k) * 4); fa[j] += xv[0] * w[0] + xv[1] * w[1] + xv[2] * w[2] + xv[3] * w[3]; }
        }
        const bool h5 = (lane & 32) != 0, h4 = (lane & 16) != 0, h3 = (lane & 8) != 0;
        float a4[4], a2[2];
#pragma unroll
        for (int j = 0; j < 4; ++j) { const float keep = h5 ? fa[4 + j] : fa[j], send = h5 ? fa[j] : fa[4 + j]; a4[j] = keep + __shfl_xor(send, 32); }
#pragma unroll
        for (int j = 0; j < 2; ++j) { const float keep = h4 ? a4[2 + j] : a4[j], send = h4 ? a4[j] : a4[2 + j]; a2[j] = keep + __shfl_xor(send, 16); }
        float c1;
        { const float keep = h3 ? a2[1] : a2[0], send = h3 ? a2[0] : a2[1]; c1 = keep + __shfl_xor(send, 8); }
        c1 += __shfl_xor(c1, 4); c1 += __shfl_xor(c1, 2); c1 += __shfl_xor(c1, 1);
        if ((lane & 7) == 0) {
            const float z = c1 + bfv;
            lf_out[lane >> 3] = fminf(z, 0.f) - log1pf(expf(-fabsf(z)));
        }
    }
    for (int i = blockIdx.x * NT + tid; i < NR; i += gridDim.x * NT) p.rowss[i] = 0.f;
    if (blockIdx.x == 0 && tid < 128) p.ctrl[tid] = 0u;
}

namespace pg8 {
#define PG8_LAS __attribute__((address_space(3)))
typedef unsigned short bf16_t;
typedef short bf16x8 __attribute__((ext_vector_type(8)));
typedef float f32x4 __attribute__((ext_vector_type(4)));
typedef unsigned u32x4 __attribute__((ext_vector_type(4)));
constexpr int BM = 256, BK = 64, HALF = 128, HTB = HALF * BK * 2  , STAGE_BYTES = 8 * HTB, NXCD = 8, WGM = 8;

__host__ __device__ __forceinline__ int lds_byte(int r, int c) { const int st = (r >> 4) * 2 + (c >> 5), rr = r & 15, cc = c & 31, ob = rr * 64 + cc * 2; return st * 1024 + (ob ^ (((ob >> 9) & 1) << 5)); }
__host__ __device__ __forceinline__ void stage_rc(int b, int& R, int& C) { const int st = b / 1024, sb = b % 1024, swz = sb ^ (((sb >> 9) & 1) << 5); R = (st >> 1) * 16 + swz / 64; C = (st & 1) * 32 + (swz % 64) / 2; }
__host__ __device__ __forceinline__ int perm32(int rho) { const int n = rho >> 4, i = rho & 15; return 8 * (i >> 2) + 4 * n + (i & 3); }

struct Unit { int pm, pn; };
struct Gemm { const bf16_t* A; const bf16_t* Bt; int M, N, K; };

struct StaticOrder {
    int nM, nN, nwg, G, c;
    __host__ __device__ void init(int M, int N, int G_, int c_) { nM = M / BM; nN = N / BM; nwg = nM * nN; G = G_; c = c_; }
    __host__ __device__ bool next(int i, Unit& u) const {
        const long L = (long)i * G + c; if (L >= nwg) return false;
        int wgid = (int)L; { const int q = nwg / NXCD, r = nwg % NXCD, xcd = wgid % NXCD, off = wgid / NXCD; wgid = (xcd < r ? xcd * (q + 1) : r * (q + 1) + (xcd - r) * q) + off; }
        const int nig = WGM * nN, gid = wgid / nig, fm = gid * WGM, gsz = (nM - fm) < WGM ? (nM - fm) : WGM;
        u.pm = fm + ((wgid % nig) % gsz); u.pn = (wgid % nig) / gsz; return true;
    }
    __device__ __forceinline__ void a_ready(const Unit&) const {}
    __device__ __forceinline__ void done(const Unit&) const {}
};

template <class Epi, class Sched, bool ALIGN_EPI = false, bool SP2 = false>
__device__ __forceinline__ void gemm_phase(PG8_LAS unsigned char* lds, const Gemm g, const Sched& S, const Epi& E) {
    const int tid = threadIdx.x, wid = __builtin_amdgcn_readfirstlane(tid >> 6), lane = tid & 63, wr = wid >> 2, wc = wid & 3, fr = lane & 15, fq = lane >> 4;
    const int K = g.K, nt = K / BK;
    unsigned voffA[2], voffB[2];
#pragma unroll
    for (int i = 0; i < 2; ++i) { int R, C; stage_rc(tid * 16 + i * 8192, R, C); const int Rb = Epi::PERM ? ((R & ~31) + perm32(R & 31)) : R;
        voffA[i] = (unsigned)(R * K + C) * 2u; voffB[i] = (unsigned)(Rb * K + C) * 2u; }
    const size_t kstep = (size_t)(BK * 2);
    const size_t hstep = (size_t)HALF * K * 2;
    const size_t tstep = 2 * hstep;
    const unsigned ldsw = (unsigned)wid * 1024u;
    const int aoff = lds_byte(wr * 64 + fr, fq * 8), boff = lds_byte(wc * 32 + fr, fq * 8);
#define PG8_SA(b, h) (((b) * 2 + (h)) * HTB)
#define PG8_SB(b, h) ((4 + (b) * 2 + (h)) * HTB)
#define PG8_STAGE(bufoff, gbase, voff) do { _Pragma("unroll") for (int _i = 0; _i < 2; ++_i) \
        __builtin_amdgcn_global_load_lds((const unsigned*)((const char*)(gbase) + (voff)[_i]), (PG8_LAS unsigned*)(lds + (bufoff) + ldsw + _i * 8192), 16, 0, 0); } while (0)
#define PG8_LDA(dst, b, h) do { _Pragma("unroll") for (int m = 0; m < 4; ++m) _Pragma("unroll") for (int k = 0; k < 2; ++k) dst[m][k] = *(const PG8_LAS bf16x8*)(lds + PG8_SA(b, h) + aoff + m * 2048 + k * 1024); } while (0)
#define PG8_LDB(dst, b, h) do { _Pragma("unroll") for (int n = 0; n < 2; ++n) _Pragma("unroll") for (int k = 0; k < 2; ++k) dst[n][k] = *(const PG8_LAS bf16x8*)(lds + PG8_SB(b, h) + boff + n * 2048 + k * 1024); } while (0)
#define PG8_MMA(ai, bj, At, Bt) do { __builtin_amdgcn_s_setprio(1); _Pragma("unroll") for (int m = 0; m < 4; ++m) _Pragma("unroll") for (int n = 0; n < 2; ++n) _Pragma("unroll") for (int k = 0; k < 2; ++k) \
        acc[ai][bj][m][n] = __builtin_amdgcn_mfma_f32_16x16x32_bf16(Bt[n][k], At[m][k], acc[ai][bj][m][n], 0, 0, 0); __builtin_amdgcn_s_setprio(0); } while (0)
#define PG8_WAIT_V(n) asm volatile("s_waitcnt vmcnt(" #n ")" ::: "memory")
#define PG8_WAIT_L(n) asm volatile("s_waitcnt lgkmcnt(" #n ")" ::: "memory")
#define PG8_BAR __builtin_amdgcn_s_barrier()
#define PG8_SCHED __builtin_amdgcn_sched_barrier(0)
    Unit cur, nxt; int ui = 0;
    if (!S.next(0, cur)) return;
    f32x4 acc[2][2][4][2];
#pragma unroll
    for (int a = 0; a < 2; ++a)
#pragma unroll
        for (int b = 0; b < 2; ++b)
#pragma unroll
            for (int m = 0; m < 4; ++m)
#pragma unroll
                for (int n = 0; n < 2; ++n) acc[a][b][m][n] = (f32x4){0.f, 0.f, 0.f, 0.f};
    bf16x8 At[4][2], B0[2][2], B1[2][2];
    const char* cA = (const char*)g.A + (size_t)cur.pm * tstep; const char* cB = (const char*)g.Bt + (size_t)cur.pn * tstep;
    S.a_ready(cur);
    if constexpr (SP2) {
        PG8_STAGE(PG8_SB(0, 0), cB, voffB); PG8_STAGE(PG8_SB(0, 1), cB + hstep, voffB); PG8_STAGE(PG8_SA(0, 0), cA, voffA); PG8_STAGE(PG8_SA(0, 1), cA + hstep, voffA);
        if (wr == 1) PG8_BAR;
        PG8_WAIT_V(2); PG8_BAR;
        PG8_STAGE(PG8_SB(1, 0), cB + kstep, voffB); PG8_STAGE(PG8_SA(1, 0), cA + kstep, voffA); PG8_STAGE(PG8_SB(1, 1), cB + hstep + kstep, voffB);
        PG8_WAIT_V(6); PG8_BAR;
    } else {
        PG8_STAGE(PG8_SB(0, 0), cB, voffB); PG8_STAGE(PG8_SA(0, 0), cA, voffA); PG8_STAGE(PG8_SB(0, 1), cB + hstep, voffB); PG8_STAGE(PG8_SA(0, 1), cA + hstep, voffA);
        if (wr == 1) PG8_BAR;
        PG8_WAIT_V(4); PG8_BAR;
        PG8_STAGE(PG8_SB(1, 0), cB + kstep, voffB); PG8_STAGE(PG8_SA(1, 0), cA + kstep, voffA); PG8_STAGE(PG8_SB(1, 1), cB + hstep + kstep, voffB);
        PG8_WAIT_V(6); PG8_BAR;
    }
    for (;;) {
        const bool has_next = S.next(ui + 1, nxt);
        const char* nA = has_next ? (const char*)g.A + (size_t)nxt.pm * tstep : cA; const char* nB = has_next ? (const char*)g.Bt + (size_t)nxt.pn * tstep : cB;
        for (int t = 0; t < nt; t += 2) {
            const bool last = (t == nt - 2);
            const char* a1 = cA + (size_t)(t + 1) * kstep;
            const char* a2 = last ? nA : cA + (size_t)(t + 2) * kstep; const char* b2 = last ? nB : cB + (size_t)(t + 2) * kstep;
            const char* a3 = a2 + kstep; const char* b3 = b2 + kstep;
            if (last && has_next) S.a_ready(nxt);
            if constexpr (SP2) {
            PG8_LDB(B0, 0, 0); PG8_LDB(B1, 0, 1); PG8_SCHED; PG8_LDA(At, 0, 0); PG8_STAGE(PG8_SA(1, 1), a1 + hstep, voffA);
            PG8_WAIT_V(8); PG8_WAIT_L(0); PG8_BAR; PG8_MMA(0, 0, At, B0); PG8_MMA(0, 1, At, B1); PG8_BAR; PG8_SCHED;
            PG8_LDA(At, 0, 1); PG8_STAGE(PG8_SB(0, 0), b2, voffB); PG8_STAGE(PG8_SB(0, 1), b2 + hstep, voffB); PG8_STAGE(PG8_SA(0, 0), a2, voffA);
            PG8_WAIT_V(8); PG8_WAIT_L(0); PG8_BAR; PG8_MMA(1, 0, At, B0); PG8_MMA(1, 1, At, B1); PG8_BAR; PG8_SCHED;
            PG8_LDB(B0, 1, 0); PG8_LDB(B1, 1, 1); PG8_SCHED; PG8_LDA(At, 1, 0); PG8_STAGE(PG8_SA(0, 1), a2 + hstep, voffA);
            PG8_WAIT_V(8); PG8_WAIT_L(0); PG8_BAR; PG8_MMA(0, 0, At, B0); PG8_MMA(0, 1, At, B1); PG8_BAR; PG8_SCHED;
            PG8_LDA(At, 1, 1); PG8_STAGE(PG8_SB(1, 0), b3, voffB); PG8_STAGE(PG8_SB(1, 1), b3 + hstep, voffB); PG8_STAGE(PG8_SA(1, 0), a3, voffA);
            PG8_WAIT_V(8); PG8_WAIT_L(0); PG8_BAR; PG8_MMA(1, 0, At, B0); PG8_MMA(1, 1, At, B1); PG8_BAR; PG8_SCHED;
            } else {
            PG8_LDB(B0, 0, 0); PG8_SCHED; PG8_LDA(At, 0, 0); PG8_STAGE(PG8_SA(1, 1), a1 + hstep, voffA);
            PG8_WAIT_L(8); PG8_BAR; PG8_WAIT_L(0); PG8_MMA(0, 0, At, B0); PG8_BAR; PG8_SCHED;
            PG8_LDB(B1, 0, 1); PG8_STAGE(PG8_SB(0, 0), b2, voffB);
            PG8_BAR; PG8_WAIT_L(0); PG8_MMA(0, 1, At, B1); PG8_BAR;
            PG8_LDA(At, 0, 1); PG8_STAGE(PG8_SA(0, 0), a2, voffA);
            PG8_BAR; PG8_WAIT_L(0); PG8_MMA(1, 0, At, B0); PG8_BAR; PG8_SCHED;
            PG8_STAGE(PG8_SB(0, 1), b2 + hstep, voffB);
            PG8_WAIT_V(6); PG8_BAR; PG8_MMA(1, 1, At, B1); PG8_BAR;
            PG8_LDB(B0, 1, 0); PG8_SCHED; PG8_LDA(At, 1, 0); PG8_STAGE(PG8_SA(0, 1), a2 + hstep, voffA);
            PG8_WAIT_L(8); PG8_BAR; PG8_WAIT_L(0); PG8_MMA(0, 0, At, B0); PG8_BAR; PG8_SCHED;
            PG8_LDB(B1, 1, 1); PG8_STAGE(PG8_SB(1, 0), b3, voffB);
            PG8_BAR; PG8_WAIT_L(0); PG8_MMA(0, 1, At, B1); PG8_BAR;
            PG8_LDA(At, 1, 1); PG8_STAGE(PG8_SA(1, 0), a3, voffA);
            PG8_BAR; PG8_WAIT_L(0); PG8_MMA(1, 0, At, B0); PG8_BAR; PG8_SCHED;
            PG8_STAGE(PG8_SB(1, 1), b3 + hstep, voffB);
            PG8_WAIT_V(6); PG8_BAR; PG8_MMA(1, 1, At, B1); PG8_BAR;
            }
        }
        if constexpr (ALIGN_EPI) { if (wr == 0) PG8_BAR; }
        if constexpr (!Epi::AFTER_DRAIN) { E(acc, cur, wr, wc, fr, fq); S.done(cur); }
        if (!has_next) break;
#pragma unroll
        for (int a = 0; a < 2; ++a)
#pragma unroll
            for (int b = 0; b < 2; ++b)
#pragma unroll
                for (int m = 0; m < 4; ++m)
#pragma unroll
                    for (int n = 0; n < 2; ++n) acc[a][b][m][n] = (f32x4){0.f, 0.f, 0.f, 0.f};
        cur = nxt; cA = nA; cB = nB; ++ui;
        if constexpr (ALIGN_EPI) { if (wr == 1) PG8_BAR; }
    }
    PG8_WAIT_V(0);
    if constexpr (!ALIGN_EPI) { if (wr == 0) PG8_BAR; }
    PG8_BAR;
    if constexpr (Epi::AFTER_DRAIN) { E.fused(acc, cur, wr, wc, fr, fq, lds, wid, lane); S.done(cur); }
#undef PG8_SA
#undef PG8_SB
#undef PG8_STAGE
#undef PG8_LDA
#undef PG8_LDB
#undef PG8_MMA
#undef PG8_WAIT_V
#undef PG8_WAIT_L
#undef PG8_BAR
#undef PG8_SCHED
}
}

struct EpiProj8 {
    static constexpr bool PERM = true, AFTER_DRAIN = false;
    const Params* pp;
    DI void operator()(const f32x4 (&acc)[2][2][4][2], const pg8::Unit& u, int wr, int wc, int fr, int fq) const {
        const Params& p = *pp;
        const int colt = u.pn * 256, seg = colt >> 9;
        const bool isq = (seg == 0) || (seg == 4), isg = (seg == 3) || (seg == 7), iskv = !isq && !isg;
        const int oi = seg == 1 ? 0 : seg == 2 ? 1 : seg == 5 ? 2 : 3;
#pragma unroll
        for (int ai = 0; ai < 2; ++ai)
#pragma unroll
            for (int m = 0; m < 4; ++m) {
                const int R = u.pm * 256 + ai * 128 + wr * 64 + m * 16 + fr;
                float* fo = nullptr;
                if (iskv) {
                    if (R < ROWS_P) { const int b = R / LPAD, t = R - b * LPAD; if (t < LP) fo = p.out + O_PAK + oi * PKV_SZ + ((size_t)b * LP + t) * 512 - seg * 512; }
                    else fo = p.out + O_SAK + oi * SKV_SZ + (size_t)(R - ROWS_P) * 512 - seg * 512;
                }
                bf16_t* uo = p.u + (size_t)R * NU;
#pragma unroll
                for (int bj = 0; bj < 2; ++bj) {
                    const int n = colt + bj * 128 + wc * 32 + 8 * fq;
                    f32x4 v0 = acc[ai][bj][m][0], v1 = acc[ai][bj][m][1];
                    if (fo) { *(f32x4*)(fo + n) = v0; *(f32x4*)(fo + n + 4) = v1; }
                    if (isq) { v0 = v0 * QSCALE; v1 = v1 * QSCALE; }
                    else if (isg) {
#pragma unroll
                        for (int j = 0; j < 4; ++j) { v0[j] = v0[j] / (1.0f + __expf(-v0[j])); v1[j] = v1[j] / (1.0f + __expf(-v1[j])); }
                    }
                    *(u32x4*)(uo + n) = (u32x4){pk2(v0[0], v0[1]), pk2(v0[2], v0[3]), pk2(v1[0], v1[1]), pk2(v1[2], v1[3])};
                }
            }
    }
};

struct EpiOut8 {
    static constexpr bool PERM = true, AFTER_DRAIN = false;
    const Params* pp;
    DI void operator()(const f32x4 (&acc)[2][2][4][2], const pg8::Unit& u, int wr, int wc, int fr, int fq) const {
        const Params& p = *pp;
        const int colt = u.pn * 256;
#pragma unroll
        for (int ai = 0; ai < 2; ++ai)
#pragma unroll
            for (int m = 0; m < 4; ++m) {
                const int R = u.pm * 256 + ai * 128 + wr * 64 + m * 16 + fr;
                const float* xs = nullptr; float* yd = nullptr;
                if (R < ROWS_P) { const int b = R / LPAD, t = R - b * LPAD; if (t >= NMETA && t < LP) { const size_t idx = ((size_t)b * SEQ + t - NMETA) * DM; xs = p.x_prompt + idx; yd = p.out + O_YP + idx; } }
                else { const size_t idx = (size_t)(R - ROWS_P) * DM; xs = p.x_sample + idx; yd = p.out + O_YS + idx; }
                float ss = 0.f;
                if (xs) {
#pragma unroll
                    for (int bj = 0; bj < 2; ++bj) {
                        const int n = colt + bj * 128 + wc * 32 + 8 * fq;
                        const f32x4 x0 = *(const f32x4*)(xs + n), x1 = *(const f32x4*)(xs + n + 4);
                        const f32x4 h0 = x0 + acc[ai][bj][m][0], h1 = x1 + acc[ai][bj][m][1];
                        *(f32x4*)(yd + n) = h0; *(f32x4*)(yd + n + 4) = h1;
                        ss += h0[0] * h0[0] + h0[1] * h0[1] + h0[2] * h0[2] + h0[3] * h0[3] + h1[0] * h1[0] + h1[1] * h1[1] + h1[2] * h1[2] + h1[3] * h1[3];
                    }
                }
                ss += __shfl_xor(ss, 16); ss += __shfl_xor(ss, 32);
                if (xs && fq == 0) atomicAdd(p.rowss + R, ss);
            }
    }
};

DI void scan_unit(const Params& p, int su) {
    const int lane = threadIdx.x & 63, wave = threadIdx.x >> 6;
    const int seq = su * NW + wave;
    const int e0 = lane * 65;
    float vals[65];
    if (seq < 32) {
        const int b = seq >> 3, h = seq & 7;
        const float* src = p.out + O_PBL + (size_t)b * LP * 8 + h;
        float* dst = p.c2p + (size_t)seq * LPAD;
#pragma unroll
        for (int i = 0; i < 65; ++i) { const int e = e0 + i; vals[i] = src[(size_t)(e < LP ? e : LP - 1) * 8]; }
        float s = 0.f;
#pragma unroll
        for (int i = 0; i < 65; ++i) s += (e0 + i < LP) ? vals[i] : 0.f;
        float incl = s;
#pragma unroll
        for (int o = 1; o < 64; o <<= 1) { const float t = __shfl_up(incl, o); if (lane >= o) incl += t; }
        float run = incl - s;
#pragma unroll
        for (int i = 0; i < 65; ++i) { const int e = e0 + i; if (e < LP) { run += vals[i]; dst[e] = run * LOG2E; } else dst[e] = 0.f; }
    } else {
        const int sq = seq - 32, bb = sq >> 3, h = sq & 7;
        const float* src0 = p.cbl + (size_t)bb * PAST * 8 + h;
        const float* src1 = p.out + O_SBL + (size_t)bb * DSQ * 8 + h;
        float* dst = p.c2s + (size_t)sq * LSK;
#pragma unroll
        for (int i = 0; i < 65; ++i) {
            const int e = e0 + i, ec = e < LSK ? e : LSK - 1;
            const float* pe = ec < PAST ? src0 + (size_t)ec * 8 : src1 + (size_t)(ec - PAST) * 8;
            vals[i] = *pe;
        }
        float s = 0.f;
#pragma unroll
        for (int i = 0; i < 65; ++i) s += (e0 + i < LSK) ? vals[i] : 0.f;
        float incl = s;
#pragma unroll
        for (int o = 1; o < 64; o <<= 1) { const float t = __shfl_up(incl, o); if (lane >= o) incl += t; }
        float run = incl - s;
#pragma unroll
        for (int i = 0; i < 65; ++i) { const int e = e0 + i; if (e < LSK) { run += vals[i]; dst[e] = run * LOG2E; } }
    }
}

struct AttnState { f32x16 o0, o1; float m, l; };

template <int MODE>
DI void attn_subtile(LDS_AS const char* Kl, LDS_AS const char* Vl, LDS_AS const char* biasl, const bf16x8 (&q)[4], AttnState& st, int kpos0, int qpos, bool need_mask, int lane) {
    const int l31 = lane & 31, hh = lane >> 5;
    f32x16 s;
    if (MODE == 1) {
#pragma unroll
        for (int g = 0; g < 4; ++g) { const f32x4 bv = *(LDS_AS const f32x4*)(biasl + (8 * g + 4 * hh) * 4); s[4 * g] = bv[0]; s[4 * g + 1] = bv[1]; s[4 * g + 2] = bv[2]; s[4 * g + 3] = bv[3]; }
    } else {
#pragma unroll
        for (int i = 0; i < 16; ++i) s[i] = 0.f;
    }
#pragma unroll
    for (int stp = 0; stp < 4; ++stp) { const bf16x8 kf = *(LDS_AS const bf16x8*)(Kl + l31 * 144 + (2 * stp + hh) * 16); s = MFMA(kf, q[stp], s); }
    if (MODE == 1) {
        if (need_mask) {
#pragma unroll
            for (int i = 0; i < 16; ++i) if (kpos0 + crow(i, hh) > qpos) s[i] = -INFINITY;
        }
        float mx = s[0];
#pragma unroll
        for (int i = 1; i < 16; ++i) mx = fmaxf(mx, s[i]);
        mx = fmaxf(mx, __shfl_xor(mx, 32));
        const float mn = fmaxf(st.m, mx);
        if (__any(mn > st.m)) { const float a = __builtin_amdgcn_exp2f(st.m - mn); st.o0 = st.o0 * a; st.o1 = st.o1 * a; st.l *= a; }
        st.m = mn;
        float ps = 0.f;
#pragma unroll
        for (int i = 0; i < 16; ++i) { s[i] = __builtin_amdgcn_exp2f(s[i] - mn); ps += s[i]; }
        st.l += ps;
    } else {
        f32x16 lk;
#pragma unroll
        for (int i = 0; i < 16; ++i) {
            const float z = s[i];
            const float e = __builtin_amdgcn_exp2f(-fabsf(z));
            const float sp = __builtin_amdgcn_logf(1.0f + e);
            float lkv = -fmaxf(z, 0.f) - sp;
            float lsv = z + lkv;
            if (need_mask && (kpos0 + crow(i, hh) >= qpos)) { lkv = 0.f; lsv = -INFINITY; }
            lk[i] = lkv; s[i] = lsv;
        }
        float tot[4], suf1[4], suf0[4];
#pragma unroll
        for (int g = 0; g < 4; ++g) { suf1[g] = lk[4 * g + 3] + lk[4 * g + 2]; suf0[g] = suf1[g] + lk[4 * g + 1]; tot[g] = suf0[g] + lk[4 * g]; }
        float pb[4], cs[4];
#pragma unroll
        for (int g = 0; g < 4; ++g) { pb[g] = __shfl_xor(tot[g], 32); cs[g] = tot[g] + pb[g]; }
        const float S3 = 0.f, S2 = cs[3], S1 = S2 + cs[2], S0 = S1 + cs[1], total = S0 + cs[0];
        const float Sg[4] = {S0, S1, S2, S3};
#pragma unroll
        for (int g = 0; g < 4; ++g) {
            const float base = st.l + Sg[g] + (hh == 0 ? pb[g] : 0.f);
            s[4 * g + 3] = __builtin_amdgcn_exp2f(s[4 * g + 3] + base);
            s[4 * g + 2] = __builtin_amdgcn_exp2f(s[4 * g + 2] + (base + lk[4 * g + 3]));
            s[4 * g + 1] = __builtin_amdgcn_exp2f(s[4 * g + 1] + (base + suf1[g]));
            s[4 * g + 0] = __builtin_amdgcn_exp2f(s[4 * g + 0] + (base + suf0[g]));
        }
        st.l += total;
    }
    bf16x8 pf[2];
#pragma unroll
    for (int s2 = 0; s2 < 2; ++s2) {
        u32x4 w;
        w[0] = pk2(s[8 * s2 + 0], s[8 * s2 + 1]); w[1] = pk2(s[8 * s2 + 2], s[8 * s2 + 3]);
        w[2] = pk2(s[8 * s2 + 4], s[8 * s2 + 5]); w[3] = pk2(s[8 * s2 + 6], s[8 * s2 + 7]);
        pf[s2] = __builtin_bit_cast(bf16x8, w);
    }
    const int i16 = lane & 15, qq = i16 >> 2, pp = i16 & 3, gg = (lane >> 4) & 1;
#pragma unroll
    for (int s2 = 0; s2 < 2; ++s2)
#pragma unroll
        for (int dt = 0; dt < 2; ++dt) {
            LDS_AS const char* a_lo = Vl + (16 * s2 + 4 * hh + qq) * 144 + (32 * dt + 16 * gg + 4 * pp) * 2;
            const s16x4 lo = __builtin_amdgcn_ds_read_tr16_b64_v4i16((LDS_AS s16x4*)a_lo);
            const s16x4 hi = __builtin_amdgcn_ds_read_tr16_b64_v4i16((LDS_AS s16x4*)(a_lo + 8 * 144));
            const bf16x8 vf = __builtin_shufflevector(lo, hi, 0, 1, 2, 3, 4, 5, 6, 7);
            if (dt == 0) st.o0 = MFMA(vf, pf[s2], st.o0); else st.o1 = MFMA(vf, pf[s2], st.o1);
        }
}

DI void fox_softmax32(f32x16& s, AttnState& st, bf16x8 (&pf)[2]) {
    float mx = max2f(s[0], s[1]);
#pragma unroll
    for (int i = 2; i < 16; i += 2) mx = max3f(mx, s[i], s[i + 1]);
    mx = max2f(mx, __shfl_xor(mx, 32));
    const float mn = max2f(st.m, mx);
    if (__any(mn > st.m)) { const float a = __builtin_amdgcn_exp2f(st.m - mn); st.o0 = st.o0 * a; st.o1 = st.o1 * a; st.l *= a; }
    st.m = mn;
    const f32x2 mn2 = {mn, mn};
    f32x2 acc2 = {0.f, 0.f};
#pragma unroll
    for (int i = 0; i < 16; i += 2) {
        f32x2 t = {s[i], s[i + 1]};
        t = t - mn2;
        t[0] = __builtin_amdgcn_exp2f(t[0]); t[1] = __builtin_amdgcn_exp2f(t[1]);
        acc2 = acc2 + t;
        s[i] = t[0]; s[i + 1] = t[1];
    }
    st.l += acc2[0] + acc2[1];
#pragma unroll
    for (int s2 = 0; s2 < 2; ++s2) {
        u32x4 w;
        w[0] = pk2(s[8 * s2 + 0], s[8 * s2 + 1]); w[1] = pk2(s[8 * s2 + 2], s[8 * s2 + 3]); w[2] = pk2(s[8 * s2 + 4], s[8 * s2 + 5]); w[3] = pk2(s[8 * s2 + 6], s[8 * s2 + 7]);
        pf[s2] = __builtin_bit_cast(bf16x8, w);
    }
}
DI void fox_pv32(LDS_AS const char* Vl, const bf16x8 (&pf)[2], AttnState& st, int lane) {
    const int hh = lane >> 5, i16 = lane & 15, qq = i16 >> 2, pp = i16 & 3, gg = (lane >> 4) & 1;
#pragma unroll
    for (int s2 = 0; s2 < 2; ++s2)
#pragma unroll
        for (int dt = 0; dt < 2; ++dt) {
            LDS_AS const char* a_lo = Vl + (16 * s2 + 4 * hh + qq) * 144 + (32 * dt + 16 * gg + 4 * pp) * 2;
            const s16x4 lo = __builtin_amdgcn_ds_read_tr16_b64_v4i16((LDS_AS s16x4*)a_lo);
            const s16x4 hi = __builtin_amdgcn_ds_read_tr16_b64_v4i16((LDS_AS s16x4*)(a_lo + 8 * 144));
            const bf16x8 vf = __builtin_shufflevector(lo, hi, 0, 1, 2, 3, 4, 5, 6, 7);
            if (dt == 0) st.o0 = MFMA(vf, pf[s2], st.o0); else st.o1 = MFMA(vf, pf[s2], st.o1);
        }
}
DI void attn_tile64_fox(LDS_AS const char* Kl, LDS_AS const char* Vl, LDS_AS const char* biasl, const bf16x8 (&q)[4], AttnState& st, int lane) {
    const int l31 = lane & 31, hh = lane >> 5;
    f32x16 s0, s1;
#pragma unroll
    for (int g = 0; g < 4; ++g) {
        const f32x4 b0 = *(LDS_AS const f32x4*)(biasl + (8 * g + 4 * hh) * 4);
        const f32x4 b1 = *(LDS_AS const f32x4*)(biasl + 128 + (8 * g + 4 * hh) * 4);
        s0[4 * g] = b0[0]; s0[4 * g + 1] = b0[1]; s0[4 * g + 2] = b0[2]; s0[4 * g + 3] = b0[3];
        s1[4 * g] = b1[0]; s1[4 * g + 1] = b1[1]; s1[4 * g + 2] = b1[2]; s1[4 * g + 3] = b1[3];
    }
    bf16x8 k0[4], k1[4];
#pragma unroll
    for (int stp = 0; stp < 4; ++stp) {
        k1[stp] = *(LDS_AS const bf16x8*)(Kl + 32 * 144 + l31 * 144 + (2 * stp + hh) * 16);
        k0[stp] = *(LDS_AS const bf16x8*)(Kl + l31 * 144 + (2 * stp + hh) * 16);
    }
#pragma unroll
    for (int stp = 0; stp < 4; ++stp) s1 = MFMA(k1[stp], q[stp], s1);
#pragma unroll
    for (int stp = 0; stp < 4; ++stp) s0 = MFMA(k0[stp], q[stp], s0);
    __builtin_amdgcn_sched_barrier(0);
    bf16x8 pf1[2], pf0[2];
    fox_softmax32(s1, st, pf1);
    __builtin_amdgcn_sched_barrier(0);
    fox_pv32(Vl + 32 * 144, pf1, st, lane);
    __builtin_amdgcn_sched_barrier(0);
    fox_softmax32(s0, st, pf0);
    __builtin_amdgcn_sched_barrier(0);
    fox_pv32(Vl, pf0, st, lane);
}

DI void store_gated(const AttnState& st, const bf16_t* sg, bf16_t* mo, int hh) {
#pragma unroll
    for (int dt = 0; dt < 2; ++dt)
#pragma unroll
        for (int g = 0; g < 4; ++g) {
            const int d = 32 * dt + 8 * g + 4 * hh;
            const u32x2 gv = *(const u32x2*)(sg + d);
            const f32x16& o = dt == 0 ? st.o0 : st.o1;
            const float a0 = o[4 * g] * bflo(gv[0]), a1 = o[4 * g + 1] * bfhi(gv[0]), a2 = o[4 * g + 2] * bflo(gv[1]), a3 = o[4 * g + 3] * bfhi(gv[1]);
            *(u32x2*)(mo + d) = (u32x2){pk2(a0, a1), pk2(a2, a3)};
        }
}

constexpr int PSTG = 18688;

template <int MODE>
DI void prompt_unit(const Params& p, int b, int h, int qt, char* smem) {
    int tid_ = threadIdx.x; asm volatile("" : "+v"(tid_));
    const int tid = tid_, lane = tid & 63, wave = tid >> 6, l31 = lane & 31, hh = lane >> 5;
    LDS_AS char* lb = (LDS_AS char*)smem;
    const int t0 = qt * 256, wq0 = t0 + 32 * wave;
    const int qpos = wq0 + l31;
    const bool wave_valid = wq0 < LP;
    const int qcol = (MODE == 0 ? 0 : 2048) + h * 64, kcol = qcol + 512, vcol = qcol + 1024, gcol = qcol + 1536;
    const size_t rowb = (size_t)b * LPAD;
    bf16x8 q[4];
    {
        const int qr = qpos < LPAD ? qpos : LPAD - 1;
        const bf16_t* qp = p.u + (rowb + qr) * NU + qcol + 8 * hh;
#pragma unroll
        for (int s = 0; s < 4; ++s) q[s] = *(const bf16x8*)(qp + 16 * s);
    }
    AttnState st;
#pragma unroll
    for (int i = 0; i < 16; ++i) { st.o0[i] = 0.f; st.o1[i] = 0.f; }
    st.m = -1e30f; st.l = 0.f;
    const int kt_max = (4 * qt + 3) < 64 ? (4 * qt + 3) : 64;
    const float* cb = p.c2p + (size_t)(b * 8 + h) * LPAD;
    float cref = 0.f;
    if (MODE == 1) cref = cb[t0 < LP ? t0 : LP - 1];
    u32x4 rk, rv; float rbias = 0.f;
    const int r0 = tid >> 3, c0 = tid & 7;
    auto pload = [&](int kt) {
        const bf16_t* kb = p.u + (rowb + (size_t)kt * 64 + r0) * NU + c0 * 8;
        rk = *(const u32x4*)(kb + kcol); rv = *(const u32x4*)(kb + vcol);
        if (MODE == 1 && tid < 64) rbias = cref - cb[kt * 64 + tid];
    };
    auto pstore = [&](int sg) {
        LDS_AS char* base = lb + sg * PSTG + r0 * 144 + c0 * 16;
        *(LDS_AS u32x4*)(base) = rk; *(LDS_AS u32x4*)(base + 9216) = rv;
        if (MODE == 1 && tid < 64) *(LDS_AS float*)(lb + sg * PSTG + 18432 + tid * 4) = rbias;
    };
    __syncthreads();
    pload(kt_max); pstore(0);
    __syncthreads();
    int stg = 0;
    bool wdone = !wave_valid;
    for (int kt = kt_max; kt >= 0; --kt) {
        if (kt > 0) pload(kt - 1);
        if (!wdone) {
            LDS_AS const char* sb = lb + stg * PSTG;
            if (MODE == 1 && kt * 64 + 63 < wq0) attn_tile64_fox(sb, sb + 9216, sb + 18432, q, st, lane);
            else
#pragma unroll
            for (int sub = 1; sub >= 0; --sub) {
                const int kp0 = kt * 64 + sub * 32;
                if (kp0 <= wq0 + 31) {
                    const bool nm = (kp0 + 31 >= wq0);
                    attn_subtile<MODE>(sb + sub * 32 * 144, sb + 9216 + sub * 32 * 144, sb + 18432 + sub * 128, q, st, kp0, qpos, nm, lane);
                }
            }
            if (MODE == 0) wdone = __all(st.l < -SB_THRESH);
        }
        if (kt > 0) pstore(stg ^ 1);
        if (MODE == 0) { if (__syncthreads_and(wdone ? 1 : 0)) break; }
        else __syncthreads();
        stg ^= 1;
    }
    if (MODE == 1) { const float lt = st.l + __shfl_xor(st.l, 32); const float inv = 1.0f / lt; st.o0 = st.o0 * inv; st.o1 = st.o1 * inv; }
    if (wave_valid && qpos < LP) store_gated(st, p.u + (rowb + qpos) * NU + gcol, p.mix + (rowb + qpos) * DM + (MODE == 0 ? 0 : 512) + h * 64, hh);
}

DI void prompt_sb_unit(const Params& p, int b, int h, int qt, char* smem) {
    int tid_ = threadIdx.x; asm volatile("" : "+v"(tid_));
    const int tid = tid_, lane = tid & 63, wave = tid >> 6, l31 = lane & 31, hh = lane >> 5;
    LDS_AS char* lb = (LDS_AS char*)smem + wave * 9216;
    const int wq0 = qt * 256 + 32 * wave, qpos = wq0 + l31;
    const int qcol = h * 64, kcol = qcol + 512, vcol = qcol + 1024, gcol = qcol + 1536;
    const size_t rowb = (size_t)b * LPAD;
    __syncthreads();
    if (wq0 < LP) {
        bf16x8 q[4];
        {
            const bf16_t* qp = p.u + (rowb + qpos) * NU + qcol + 8 * hh;
#pragma unroll
            for (int s = 0; s < 4; ++s) q[s] = *(const bf16x8*)(qp + 16 * s);
        }
        AttnState st;
#pragma unroll
        for (int i = 0; i < 16; ++i) { st.o0[i] = 0.f; st.o1[i] = 0.f; }
        st.m = -1e30f; st.l = 0.f;
        u32x4 rk[4], rv[4];
        const int r0 = lane >> 3, c0 = lane & 7;
        const bf16_t* ub = p.u + (rowb + r0) * NU + c0 * 8;
        int kp = wq0;
        {
            const bf16_t* kb = ub + (size_t)kp * NU;
#pragma unroll
            for (int i = 0; i < 4; ++i) { rk[i] = *(const u32x4*)(kb + (size_t)(8 * i) * NU + kcol); rv[i] = *(const u32x4*)(kb + (size_t)(8 * i) * NU + vcol); }
        }
        for (;;) {
            asm volatile("s_waitcnt lgkmcnt(0)" ::: "memory");
#pragma unroll
            for (int i = 0; i < 4; ++i) { *(LDS_AS u32x4*)(lb + (r0 + 8 * i) * 144 + c0 * 16) = rk[i]; *(LDS_AS u32x4*)(lb + 4608 + (r0 + 8 * i) * 144 + c0 * 16) = rv[i]; }
            const int kn = kp - 32;
            if (kn >= 0) {
                const bf16_t* kb = ub + (size_t)kn * NU;
#pragma unroll
                for (int i = 0; i < 4; ++i) { rk[i] = *(const u32x4*)(kb + (size_t)(8 * i) * NU + kcol); rv[i] = *(const u32x4*)(kb + (size_t)(8 * i) * NU + vcol); }
            }
            asm volatile("s_waitcnt lgkmcnt(0)" ::: "memory");
            attn_subtile<0>(lb, lb + 4608, lb, q, st, kp, qpos, kp == wq0, lane);
            if (kn < 0 || __all(st.l < -SB_THRESH)) break;
            kp = kn;
        }
        if (qpos < LP) store_gated(st, p.u + (rowb + qpos) * NU + gcol, p.mix + (rowb + qpos) * DM + h * 64, hh);
    }
}

template <int MODE>
DI void sample_unit(const Params& p, int bb, int split, char* smem, int cq = 0) {
    int tid_ = threadIdx.x; asm volatile("" : "+v"(tid_));
    const int tid = tid_, lane = tid & 63, wave = tid >> 6, l31 = lane & 31, hh = lane >> 5;
    LDS_AS char* lb = (LDS_AS char*)smem;
    const int h = wave;
    const int qpos = PAST + l31;
    const size_t Rq = (size_t)ROWS_P + bb * 32 + l31;
    const int segb = (MODE == 0 ? 0 : 2048);
    const int qcol = segb + h * 64, gcol = qcol + 1536;
    bf16x8 q[4];
    {
        const bf16_t* qp = p.u + Rq * NU + qcol + 8 * hh;
#pragma unroll
        for (int s = 0; s < 4; ++s) q[s] = *(const bf16x8*)(qp + 16 * s);
    }
    AttnState st;
#pragma unroll
    for (int i = 0; i < 16; ++i) { st.o0[i] = 0.f; st.o1[i] = 0.f; }
    st.m = -1e30f; st.l = 0.f;
    const float* ck = (MODE == 0 ? p.cak : p.cbk) + (size_t)bb * PAST * 512;
    const float* cv = (MODE == 0 ? p.cav : p.cbv) + (size_t)bb * PAST * 512;
    const int ntc = (MODE == 1 ? (PAST / NSPLIT / 32) : 128), kbase = (MODE == 1 ? (PAST / NSPLIT) * split : 0);
    const bool has_new = (MODE == 0) || (split == NSPLIT - 1);
    const float* cseq = p.c2s + (size_t)(bb * 8 + ((tid >> 5) & 7)) * LSK;
    float cref = 0.f;
    if (MODE == 1 && tid < 256) cref = cseq[PAST];
    constexpr int KOFF = 0, VOFF = 36864, BOFF = 73728, HSTR = 4608;
    bool wdone = false, alldone = false;
    if (has_new) {
        __syncthreads();
        const bf16_t* kb = p.u + ((size_t)ROWS_P + bb * 32) * NU + segb + 512;
#pragma unroll
        for (int i = 0; i < 4; ++i) {
            const int id = tid + 512 * i, r = id >> 6, c = id & 63, hd = c >> 3, d = (c & 7) * 8;
            const u32x4 kx = *(const u32x4*)(kb + (size_t)r * NU + c * 8);
            const u32x4 vx = *(const u32x4*)(kb + (size_t)r * NU + 512 + c * 8);
            *(LDS_AS u32x4*)(lb + KOFF + hd * HSTR + r * 144 + d * 2) = kx;
            *(LDS_AS u32x4*)(lb + VOFF + hd * HSTR + r * 144 + d * 2) = vx;
        }
        if (MODE == 1 && tid < 256) *(LDS_AS float*)(lb + BOFF + tid * 4) = cref - cseq[PAST + (tid & 31)];
        __syncthreads();
        attn_subtile<MODE>(lb + KOFF + wave * HSTR, lb + VOFF + wave * HSTR, lb + BOFF + wave * 128, q, st, PAST, qpos, true, lane);
        if (MODE == 0) { wdone = __all(st.l < -SB_THRESH); alldone = __syncthreads_and(wdone ? 1 : 0) != 0; }
    }
    if (!alldone) {
        f32x4 tk[8], tv[8]; float tb = 0.f;
        const int rot = (MODE == 1) ? ((bb * NSPLIT + split) * 5) % ntc : 0;
        {
            const int t0i = (ntc - 1 + rot) % ntc;
            const float* kg = ck + (size_t)(kbase + 32 * t0i) * 512;
            const float* vg = cv + (size_t)(kbase + 32 * t0i) * 512;
            if (MODE == 1 && tid < 256) tb = cseq[kbase + 32 * t0i + (tid & 31)];
#pragma unroll
            for (int i = 0; i < 8; ++i) { const int id = tid + 512 * i; tk[i] = __builtin_nontemporal_load((const f32x4*)(kg + (size_t)id * 4)); tv[i] = __builtin_nontemporal_load((const f32x4*)(vg + (size_t)id * 4)); }
        }
        for (int it = ntc - 1; it >= 0; --it) {
            const int kpos0 = kbase + 32 * ((it + rot) % ntc);
            const int kposn = kbase + 32 * ((it - 1 + rot + ntc) % ntc);
            __syncthreads();
#pragma unroll
            for (int i = 0; i < 8; ++i) {
                const int id = tid + 512 * i, r = id >> 7, c4 = id & 127, hd = c4 >> 4, d = (c4 & 15) * 4;
                *(LDS_AS u32x2*)(lb + KOFF + hd * HSTR + r * 144 + d * 2) = (u32x2){pk2(tk[i][0], tk[i][1]), pk2(tk[i][2], tk[i][3])};
                *(LDS_AS u32x2*)(lb + VOFF + hd * HSTR + r * 144 + d * 2) = (u32x2){pk2(tv[i][0], tv[i][1]), pk2(tv[i][2], tv[i][3])};
            }
            if (MODE == 1 && tid < 256) *(LDS_AS float*)(lb + BOFF + tid * 4) = cref - tb;
            if (it > 0) {
                const float* kg = ck + (size_t)kposn * 512;
                const float* vg = cv + (size_t)kposn * 512;
                if (MODE == 1 && tid < 256) tb = cseq[kposn + (tid & 31)];
#pragma unroll
                for (int i = 0; i < 8; ++i) { const int id = tid + 512 * i; tk[i] = __builtin_nontemporal_load((const f32x4*)(kg + (size_t)id * 4)); tv[i] = __builtin_nontemporal_load((const f32x4*)(vg + (size_t)id * 4)); }
            }
            __builtin_amdgcn_sched_barrier(0);
            __syncthreads();
            if (!wdone) {
                attn_subtile<MODE>(lb + KOFF + wave * HSTR, lb + VOFF + wave * HSTR, lb + BOFF + wave * 128, q, st, kpos0, qpos, false, lane);
                if (MODE == 0) wdone = __all(st.l < -SB_THRESH);
            }
            if (MODE == 0) { if (__syncthreads_and(wdone ? 1 : 0)) break; }
        }
    }
    if (MODE == 0) {
        store_gated(st, p.u + Rq * NU + gcol, p.mix + Rq * DM + h * 64, hh);
        return;
    }
    {
        const float lt = st.l + __shfl_xor(st.l, 32);
        float* pp = p.part + ((((size_t)bb * NSPLIT + split) * 8) + wave) * PART_STRIDE;
        if (hh == 0) { pp[l31] = st.m; pp[32 + l31] = lt; }
#pragma unroll
        for (int dt = 0; dt < 2; ++dt)
#pragma unroll
            for (int g = 0; g < 4; ++g) {
                const int d = 32 * dt + 8 * g + 4 * hh;
                const f32x16& o = dt == 0 ? st.o0 : st.o1;
                *(f32x4*)(pp + 64 + l31 * 64 + d) = (f32x4){o[4 * g], o[4 * g + 1], o[4 * g + 2], o[4 * g + 3]};
            }
    }
    asm volatile("s_waitcnt vmcnt(0)" ::: "memory");
    __syncthreads();
    LDS_AS int* sflag = (LDS_AS int*)((LDS_AS char*)smem + SM_UNIT_OFF + 4);
    if (tid == 0) {
        __builtin_amdgcn_fence(__ATOMIC_RELEASE, "agent");
        asm volatile("s_waitcnt vmcnt(0)" ::: "memory");
        const unsigned old = __hip_atomic_fetch_add(p.ctrl + cq + 8 + bb, 1u, __ATOMIC_RELAXED, __HIP_MEMORY_SCOPE_AGENT);
        const int lastf = (old == (unsigned)(NSPLIT - 1)) ? 1 : 0;
        if (lastf) { __builtin_amdgcn_fence(__ATOMIC_ACQUIRE, "agent"); asm volatile("s_waitcnt vmcnt(0)" ::: "memory"); }
        *sflag = lastf;
    }
    __syncthreads();
    const int last = *sflag;
    if (!last) return;
    {
        const int hd = tid >> 6, qi = (tid & 63) >> 1, d0 = (tid & 1) * 32;
        const float* pb = p.part + (((size_t)bb * NSPLIT) * 8 + hd) * PART_STRIDE;
        float M = -1e30f;
#pragma unroll
        for (int s = 0; s < NSPLIT; ++s) M = fmaxf(M, __builtin_nontemporal_load(pb + (size_t)s * 8 * PART_STRIDE + qi));
        float L = 0.f; float o[32];
#pragma unroll
        for (int j = 0; j < 32; ++j) o[j] = 0.f;
#pragma unroll 2
        for (int s = 0; s < NSPLIT; ++s) {
            const float* ps = pb + (size_t)s * 8 * PART_STRIDE;
            const float w = __builtin_amdgcn_exp2f(__builtin_nontemporal_load(ps + qi) - M);
            L += w * __builtin_nontemporal_load(ps + 32 + qi);
#pragma unroll
            for (int j = 0; j < 8; ++j) { const f32x4 v = *(const f32x4*)(ps + 64 + qi * 64 + d0 + 4 * j); o[4 * j] += w * v[0]; o[4 * j + 1] += w * v[1]; o[4 * j + 2] += w * v[2]; o[4 * j + 3] += w * v[3]; }
        }
        const float inv = 1.0f / L;
        const size_t R = (size_t)ROWS_P + bb * 32 + qi;
        const int hcol = hd * 64 + d0;
        const bf16_t* sg = p.u + R * NU + 3584 + hcol;
        bf16_t* mo = p.mix + R * DM + 512 + hcol;
#pragma unroll
        for (int j = 0; j < 8; ++j) {
            const u32x2 gv = *(const u32x2*)(sg + 4 * j);
            *(u32x2*)(mo + 4 * j) = (u32x2){pk2(o[4 * j] * inv * bflo(gv[0]), o[4 * j + 1] * inv * bfhi(gv[0])), pk2(o[4 * j + 2] * inv * bflo(gv[1]), o[4 * j + 3] * inv * bfhi(gv[1]))};
        }
    }
}

constexpr int NU_SF = DB * NSPLIT, NU_PF = 32 * 17, NU_SS = DB, NU_PS = 32 * 17;

__global__ void __launch_bounds__(512, 2) hymba_mega(Params p) {
    extern __shared__ __attribute__((aligned(16))) char smem[];
    const int tid = threadIdx.x;
    volatile LDS_AS unsigned* xbst = (volatile LDS_AS unsigned*)((LDS_AS char*)smem + 131072);
    if (tid == 0) { xbst[0] = 0u; xbst[1] = 0u; xbst[2] = 0u; xbst[3] = 0u; }
    __syncthreads();
    const XcdBarrier xb = xcd_barrier_post(p.bar, xbst);

    phase0(p, smem);
    xcd_barrier(xb);

    {
        const int su = (int)gridDim.x - 1 - (int)blockIdx.x;
        if (su < 20) scan_unit(p, su);
        __syncthreads();
        pg8::StaticOrder S; S.init(NR, 4096, (int)gridDim.x, (int)blockIdx.x);
        const pg8::Gemm g{p.xn, p.wtin, NR, 4096, DM};
        const EpiProj8 E{&p};
        pg8::gemm_phase<EpiProj8, pg8::StaticOrder, true, true>((PG8_LAS unsigned char*)smem, g, S, E);
        xcd_barrier(xb);
#if DUP_P1
        pg8::gemm_phase<EpiProj8, pg8::StaticOrder, true, true>((PG8_LAS unsigned char*)smem, g, S, E);
        xcd_barrier(xb);
#endif
    }

    for (int rep = 0; rep < 1 + DUP_P2; ++rep) {
        const int cq = rep * 64;
        LDS_AS int* sunit = (LDS_AS int*)((LDS_AS char*)smem + SM_UNIT_OFF);
#define QUEUE_LOOP(QI, NUNITS, BODY) \
        for (;;) { \
            __syncthreads(); \
            if (tid == 0) *sunit = (int)atomicAdd(p.ctrl + cq + (QI), 1u); \
            __syncthreads(); \
            const int u = *sunit; \
            if (u >= (NUNITS)) break; \
            BODY; \
        }
        const bool streamer = ((blockIdx.x >> 3) & 3) == 0;
        for (int ph = 0; ph < 4; ++ph) {
            const int qi = streamer ? (ph == 0 ? 0 : ph == 1 ? 2 : ph == 2 ? 1 : 3) : (ph == 0 ? 1 : ph == 1 ? 0 : ph == 2 ? 2 : 3);
            if (qi == 0) { QUEUE_LOOP(0, NU_SF, sample_unit<1>(p, u / NSPLIT, u % NSPLIT, smem, cq)) }
            else if (qi == 1) { QUEUE_LOOP(1, NU_PF, prompt_unit<1>(p, (u & 31) >> 3, u & 7, 16 - (u >> 5), smem)) }
            else if (qi == 2) { QUEUE_LOOP(2, NU_SS, sample_unit<0>(p, u, 0, smem)) }
            else { QUEUE_LOOP(3, NU_PS, prompt_sb_unit(p, (u & 31) >> 3, u & 7, 16 - (u >> 5), smem)) }
        }
        xcd_barrier(xb);
    }

    {
        pg8::StaticOrder S; S.init(NR, DM, (int)gridDim.x, (int)blockIdx.x);
        const pg8::Gemm g{p.mix, p.wtout, NR, DM, DM};
        const EpiOut8 E{&p};
        pg8::gemm_phase<EpiOut8, pg8::StaticOrder, true, true>((PG8_LAS unsigned char*)smem, g, S, E);
    }
    xcd_barrier(xb);

    {
        const int lane = tid & 63, wave = tid >> 6;
        auto row_dst = [&](int R) -> float* {
            if (R < ROWS_P) { const int b = R / LPAD, t = R - b * LPAD; if (t >= NMETA && t < LP) return p.out + O_YP + ((size_t)b * SEQ + t - NMETA) * DM; return nullptr; }
            return p.out + O_YS + (size_t)(R - ROWS_P) * DM;
        };
        f32x4 gq[4];
#pragma unroll
        for (int i = 0; i < 4; ++i) gq[i] = *(const f32x4*)(p.final_g + i * 256 + lane * 4);
        f32x4 vn[4]; float rn;
        {
            const int R0 = blockIdx.x * NW + wave;
            float* d0 = R0 < NR ? row_dst(R0) : nullptr; if (!d0) d0 = p.out + O_YS;
            rn = p.rowss[R0 < NR ? R0 : 0];
#pragma unroll
            for (int i = 0; i < 4; ++i) vn[i] = *(const f32x4*)(d0 + i * 256 + lane * 4);
        }
        for (int R = blockIdx.x * NW + wave; R < NR; R += gridDim.x * NW) {
            float* yd = row_dst(R);
            f32x4 v[4]; const float rs = rn;
#pragma unroll
            for (int i = 0; i < 4; ++i) v[i] = vn[i];
            {
                const int Rn = R + gridDim.x * NW;
                float* dn = Rn < NR ? row_dst(Rn) : nullptr; if (!dn) dn = p.out + O_YS;
                rn = p.rowss[Rn < NR ? Rn : 0];
#pragma unroll
                for (int i = 0; i < 4; ++i) vn[i] = *(const f32x4*)(dn + i * 256 + lane * 4);
            }
            if (!yd) continue;
            const float rstd = 1.0f / sqrtf(rs * (1.0f / 1024.0f) + EPS);
#pragma unroll
            for (int i = 0; i < 4; ++i) *(f32x4*)(yd + i * 256 + lane * 4) = v[i] * rstd * gq[i];
        }
    }
}

static inline size_t align_up(size_t x) { return (x + 255) & ~(size_t)255; }

extern "C" void kernel_launch(void* const* d_in, const int* in_sizes, int n_in, void* d_out, int out_size, void* d_ws, size_t ws_size, hipStream_t stream) {
    Params p{};
    p.x_prompt = (const float*)d_in[0]; p.x_sample = (const float*)d_in[1];
    p.cak = (const float*)d_in[2]; p.cav = (const float*)d_in[3]; p.cbk = (const float*)d_in[4]; p.cbv = (const float*)d_in[5]; p.cbl = (const float*)d_in[6];
    p.meta = (const float*)d_in[7]; p.norm_g = (const float*)d_in[8]; p.w_in = (const float*)d_in[9]; p.b_f = (const float*)d_in[10];
    p.w_out = (const float*)d_in[11]; p.final_g = (const float*)d_in[12];
    p.out = (float*)d_out;
    char* w = (char*)d_ws; size_t off = 0;
    p.ctrl = (unsigned*)(w + off); off = align_up(off + 4096);
    p.bar = (unsigned*)(w + off); off = align_up(off + XCD_BAR_WORDS * 4);
    p.rowss = (float*)(w + off); off = align_up(off + (size_t)NR * 4);
    p.wtin = (bf16_t*)(w + off); off = align_up(off + (size_t)4096 * DM * 2);
    p.wtout = (bf16_t*)(w + off); off = align_up(off + (size_t)DM * DM * 2);
    p.xn = (bf16_t*)(w + off); off = align_up(off + (size_t)NR * DM * 2);
    p.u = (bf16_t*)(w + off); off = align_up(off + (size_t)NR * NU * 2);
    p.mix = (bf16_t*)(w + off); off = align_up(off + (size_t)NR * DM * 2);
    p.c2p = (float*)(w + off); off = align_up(off + (size_t)32 * LPAD * 4);
    p.c2s = (float*)(w + off); off = align_up(off + (size_t)128 * LSK * 4);
    p.part = (float*)(w + off); off = align_up(off + (size_t)DB * NSPLIT * 8 * PART_STRIDE * 4);
    static int grid_blocks = 0;
    if (!grid_blocks) {
        int dev = 0, cus = 0, per_cu = 0;
        hipGetDevice(&dev);
        hipFuncSetAttribute((const void*)hymba_mega, hipFuncAttributeMaxDynamicSharedMemorySize, SMEM_BYTES);
        hipDeviceGetAttribute(&cus, hipDeviceAttributeMultiprocessorCount, dev);
        hipOccupancyMaxActiveBlocksPerMultiprocessor(&per_cu, hymba_mega, NT, SMEM_BYTES);
        if (per_cu > 1) per_cu = 1;
        grid_blocks = cus * per_cu;
        if (grid_blocks <= 0) grid_blocks = 256;
    }
    hipMemsetAsync(p.bar, 0, XCD_BAR_WORDS * 4, stream);
    void* args[] = {&p};
    hipError_t e = hipLaunchCooperativeKernel((void*)hymba_mega, dim3(grid_blocks), dim3(NT), args, SMEM_BYTES, stream);
    if (e != hipSuccess) fprintf(stderr, "cooperative launch failed: %s (grid %d)\n", hipGetErrorString(e), grid_blocks);
}
```
